# Optimizing an MI355X kernel written in HIP

```python
import math
import jax, jax.numpy as jnp
from jax import lax
import numpy as np

D_MODEL = 1024
BATCH = 8
SEQ = 2048
DEPTH = 4

D_INNER = 2 * D_MODEL
CONV_WIDTH = 4
EPS = 1e-6
LRU_WIDTH = D_INNER // 4
LRU_HEADS = 8
LRU_HEAD_DIM = LRU_WIDTH // LRU_HEADS
LRU_C = 8.0
HG_WIDTH = D_INNER // 4
HG_HEAD_DIM = 128
HG_HEADS = HG_WIDTH // HG_HEAD_DIM
HG_CHUNK = 64
SSD_WIDTH = D_INNER // 2
SSD_HEAD_DIM = 64
SSD_HEADS = SSD_WIDTH // SSD_HEAD_DIM
SSD_GROUPS = 2
SSD_STATE = 128
SSD_CHUNK = 128
SSD_CONV_DIM = SSD_WIDTH + 2 * SSD_GROUPS * SSD_STATE
SPLIT_SIZES = (LRU_WIDTH, LRU_WIDTH,
               HG_WIDTH, HG_WIDTH, HG_WIDTH, HG_WIDTH,
               SSD_WIDTH, SSD_CONV_DIM, SSD_HEADS)
N_IN = sum(SPLIT_SIZES)

kernel_name = "hybrid_rglru_hgrn2_ssd_parallel_heads"


def _split_points():
    return [int(v) for v in np.cumsum(SPLIT_SIZES)[:-1]]


def rmsnorm(x, w):
    xf = x.astype(jnp.float32)
    inv = lax.rsqrt(jnp.mean(xf * xf, axis=-1, keepdims=True) + EPS)
    return (xf * inv).astype(x.dtype) * w


def causal_conv(x, w, b):
    K = w.shape[0]
    S = x.shape[1]
    xp = jnp.pad(x, ((0, 0), (K - 1, 0), (0, 0)))
    out = b
    for k in range(K):
        out = out + xp[:, k:k + S] * w[k]
    return out


def rg_lru(x, wa, ba, wx, bx, lam):
    B, S, _ = x.shape
    xh = x.reshape(B, S, LRU_HEADS, LRU_HEAD_DIM)
    r = jax.nn.sigmoid(jnp.einsum('bshi,hij->bshj', xh, wa) + ba).reshape(B, S, LRU_WIDTH)
    i = jax.nn.sigmoid(jnp.einsum('bshi,hij->bshj', xh, wx) + bx).reshape(B, S, LRU_WIDTH)
    log_a = -LRU_C * r * jax.nn.softplus(-lam)
    a = jnp.exp(log_a)
    mult = jnp.sqrt(-jnp.expm1(2.0 * log_a))
    b = mult * (i * x)

    def combine(left, right):
        a1, b1 = left
        a2, b2 = right
        return a1 * a2, a2 * b1 + b2

    _, h = lax.associative_scan(combine, (a, b), axis=1)
    return h


def hgrn2_chunked(q, k, v, log_f):
    dtype = v.dtype
    q, k, v, log_f = (t.astype(jnp.float32) for t in (q, k, v, log_f))
    B, S, H, DK = q.shape
    DV = v.shape[-1]
    n = S // HG_CHUNK

    def to_chunks(t):
        return t.reshape(B, n, HG_CHUNK, H, t.shape[-1]).transpose(1, 0, 3, 2, 4)

    qc, kc, vc, lc = (to_chunks(t) for t in (q, k, v, log_f))
    causal = jnp.tril(jnp.ones((HG_CHUNK, HG_CHUNK), bool))[:, :, None]

    def step(state, inp):
        qi, ki, vi, li = inp
        cum = jnp.cumsum(li, axis=2)
        diff = cum[:, :, :, None, :] - cum[:, :, None, :, :]
        decay = jnp.where(causal, jnp.exp(jnp.where(causal, diff, 0.0)), 0.0)
        scores = jnp.einsum('bhtd,bhsd,bhtsd->bhts', qi, ki, decay)
        o = (jnp.einsum('bhts,bhsv->bhtv', scores, vi)
             + jnp.einsum('bhtd,bhdv->bhtv', qi * jnp.exp(cum), state))
        last = cum[:, :, -1:, :]
        state = (state * jnp.exp(last[:, :, 0, :, None])
                 + jnp.einsum('bhsd,bhsv->bhdv', ki * jnp.exp(last - cum), vi))
        return state, o

    s0 = jnp.zeros((B, H, DK, DV), jnp.float32)
    _, o = lax.scan(step, s0, (qc, kc, vc, lc))
    return o.transpose(1, 0, 3, 2, 4).reshape(B, S, H, DV).astype(dtype)


def ssd_chunked(x, dt, A, Bm, Cm):
    dtype = x.dtype
    x, dt, A, Bm, Cm = (t.astype(jnp.float32) for t in (x, dt, A, Bm, Cm))
    B, S, H, P = x.shape
    G, N = Bm.shape[2], Bm.shape[3]
    J = H // G
    C = SSD_CHUNK
    n = S // C
    xdt = (x * dt[..., None]).reshape(B, n, C, G, J, P).transpose(1, 0, 2, 3, 4, 5)
    dA = (dt * A).reshape(B, n, C, G, J).transpose(1, 0, 2, 3, 4)
    Bc = Bm.reshape(B, n, C, G, N).transpose(1, 0, 2, 3, 4)
    Cc = Cm.reshape(B, n, C, G, N).transpose(1, 0, 2, 3, 4)
    causal = jnp.tril(jnp.ones((C, C), bool))[:, :, None, None]

    def step(state, inp):
        xi, ai, bi, ci = inp
        cum = jnp.cumsum(ai, axis=1)
        diff = cum[:, :, None] - cum[:, None, :]
        L = jnp.where(causal, jnp.exp(jnp.where(causal, diff, 0.0)), 0.0)
        cb = jnp.einsum('btgn,bsgn->btsg', ci, bi)
        y = jnp.einsum('btsg,btsgj,bsgjp->btgjp', cb, L, xi)
        y = y + jnp.einsum('btgn,bgjpn,btgj->btgjp', ci, state, jnp.exp(cum))
        last = cum[:, -1]
        state = (state * jnp.exp(last)[..., None, None]
                 + jnp.einsum('bsgn,bsgj,bsgjp->bgjpn', bi, jnp.exp(last[:, None] - cum), xi))
        return state, y

    s0 = jnp.zeros((B, G, J, P, N), jnp.float32)
    _, y = lax.scan(step, s0, (xdt, dA, Bc, Cc))
    return y.transpose(1, 0, 2, 3, 4, 5).reshape(B, S, H, P).astype(dtype)


def setup_inputs(seed: int = 0) -> dict:
    key = jax.random.key(seed)
    ks = jax.random.split(key, 24)
    f32 = jnp.float32

    def nrm(k, shape, scale):
        return jax.random.normal(k, shape, f32) * scale

    x = nrm(ks[0], (BATCH, SEQ, D_MODEL), 1.0)
    c = nrm(ks[1], (BATCH, D_MODEL), 1.0)
    norm_w = 1.0 + nrm(ks[2], (DEPTH, D_MODEL), 0.01)
    w_ada = nrm(ks[3], (DEPTH, D_MODEL, 3 * D_MODEL), 0.5 * D_MODEL ** -0.5)
    b_ada = nrm(ks[4], (DEPTH, 3 * D_MODEL), 0.01)
    w_in = nrm(ks[5], (DEPTH, D_MODEL, N_IN), D_MODEL ** -0.5)
    lru_conv_w = nrm(ks[6], (DEPTH, CONV_WIDTH, LRU_WIDTH), CONV_WIDTH ** -0.5)
    lru_conv_b = nrm(ks[7], (DEPTH, LRU_WIDTH), 0.01)
    lru_wa = nrm(ks[8], (DEPTH, LRU_HEADS, LRU_HEAD_DIM, LRU_HEAD_DIM), LRU_HEAD_DIM ** -0.5)
    lru_ba = nrm(ks[9], (DEPTH, LRU_HEADS, LRU_HEAD_DIM), 0.01)
    lru_wx = nrm(ks[10], (DEPTH, LRU_HEADS, LRU_HEAD_DIM, LRU_HEAD_DIM), LRU_HEAD_DIM ** -0.5)
    lru_bx = nrm(ks[11], (DEPTH, LRU_HEADS, LRU_HEAD_DIM), 0.01)
    u = jax.random.uniform(ks[12], (DEPTH, LRU_WIDTH), f32, 0.9, 0.999) ** (1.0 / LRU_C)
    lru_lambda = jnp.log(u) - jnp.log1p(-u)
    hg_lb_logits = nrm(ks[13], (DEPTH, HG_WIDTH), 0.5)
    hg_norm_w = 1.0 + nrm(ks[14], (DEPTH, HG_WIDTH), 0.01)
    ssd_conv_w = nrm(ks[15], (DEPTH, CONV_WIDTH, SSD_CONV_DIM), CONV_WIDTH ** -0.5)
    ssd_conv_b = nrm(ks[16], (DEPTH, SSD_CONV_DIM), 0.01)
    dt0 = jnp.exp(jax.random.uniform(ks[17], (DEPTH, SSD_HEADS), f32, math.log(1e-3), math.log(1e-1)))
    ssd_dt_bias = dt0 + jnp.log(-jnp.expm1(-dt0))
    ssd_a_log = jnp.log(jax.random.uniform(ks[18], (DEPTH, SSD_HEADS), f32, 1.0, 16.0))
    ssd_d = 1.0 + nrm(ks[19], (DEPTH, SSD_HEADS), 0.01)
    ssd_norm_w = 1.0 + nrm(ks[20], (DEPTH, SSD_WIDTH), 0.01)
    w_out = nrm(ks[21], (DEPTH, D_INNER, D_MODEL), D_INNER ** -0.5)
    final_norm_w = 1.0 + nrm(ks[22], (D_MODEL,), 0.01)
    return {"x": x, "c": c, "norm_w": norm_w, "w_ada": w_ada, "b_ada": b_ada,
            "w_in": w_in, "lru_conv_w": lru_conv_w, "lru_conv_b": lru_conv_b,
            "lru_wa": lru_wa, "lru_ba": lru_ba, "lru_wx": lru_wx, "lru_bx": lru_bx,
            "lru_lambda": lru_lambda, "hg_lb_logits": hg_lb_logits, "hg_norm_w": hg_norm_w,
            "ssd_conv_w": ssd_conv_w, "ssd_conv_b": ssd_conv_b, "ssd_dt_bias": ssd_dt_bias,
            "ssd_a_log": ssd_a_log, "ssd_d": ssd_d, "ssd_norm_w": ssd_norm_w,
            "w_out": w_out, "final_norm_w": final_norm_w}


def reference(x, c, norm_w, w_ada, b_ada, w_in, lru_conv_w, lru_conv_b, lru_wa, lru_ba,
              lru_wx, lru_bx, lru_lambda, hg_lb_logits, hg_norm_w, ssd_conv_w, ssd_conv_b,
              ssd_dt_bias, ssd_a_log, ssd_d, ssd_norm_w, w_out, final_norm_w):
    B, S, _ = x.shape
    split_points = _split_points()
    cond = jax.nn.silu(c)
    p = jax.nn.softmax(hg_lb_logits.astype(jnp.float32), axis=0)
    lower_bounds = jnp.cumsum(p, axis=0) - p[0]

    for l in range(DEPTH):
        mod = cond @ w_ada[l] + b_ada[l]
        shift, scale, gate = jnp.split(mod, 3, axis=-1)
        h = rmsnorm(x, norm_w[l]) * (1.0 + scale[:, None]) + shift[:, None]
        u = h @ w_in[l]
        a_x, a_g, hg_q, hg_f, hg_i, hg_g, ssd_z, ssd_xbc, ssd_dt = jnp.split(u, split_points, axis=-1)

        xa = causal_conv(a_x, lru_conv_w[l], lru_conv_b[l])
        ya = rg_lru(xa, lru_wa[l], lru_ba[l], lru_wx[l], lru_bx[l], lru_lambda[l]) * jax.nn.silu(a_g)

        lb = lower_bounds[l]
        hf = hg_f.astype(jnp.float32)
        f = lb + (1.0 - lb) * jax.nn.sigmoid(hf)
        log_f = jnp.log(f)
        k_in = (1.0 - lb) * jax.nn.sigmoid(-hf)
        q_h = jax.nn.silu(hg_q).reshape(B, S, HG_HEADS, HG_HEAD_DIM)
        o_b = hgrn2_chunked(q_h, k_in.reshape(B, S, HG_HEADS, HG_HEAD_DIM),
                            hg_i.reshape(B, S, HG_HEADS, HG_HEAD_DIM),
                            log_f.reshape(B, S, HG_HEADS, HG_HEAD_DIM))
        yb = rmsnorm(o_b.reshape(B, S, HG_WIDTH), hg_norm_w[l]) * jax.nn.silu(hg_g)

        xbc = jax.nn.silu(causal_conv(ssd_xbc, ssd_conv_w[l], ssd_conv_b[l]))
        xs, Bm, Cm = jnp.split(xbc, [SSD_WIDTH, SSD_WIDTH + SSD_GROUPS * SSD_STATE], axis=-1)
        dt = jax.nn.softplus(ssd_dt + ssd_dt_bias[l])
        A = -jnp.exp(ssd_a_log[l])
        xs_h = xs.reshape(B, S, SSD_HEADS, SSD_HEAD_DIM)
        yc = ssd_chunked(xs_h, dt, A, Bm.reshape(B, S, SSD_GROUPS, SSD_STATE),
                         Cm.reshape(B, S, SSD_GROUPS, SSD_STATE))
        yc = (yc + ssd_d[l][:, None] * xs_h).reshape(B, S, SSD_WIDTH) * jax.nn.silu(ssd_z)
        yc = rmsnorm(yc.reshape(B, S, SSD_GROUPS, SSD_WIDTH // SSD_GROUPS),
                     ssd_norm_w[l].reshape(SSD_GROUPS, SSD_WIDTH // SSD_GROUPS)).reshape(B, S, SSD_WIDTH)

        y = jnp.concatenate([ya, yb, yc], axis=-1) @ w_out[l]
        x = x + gate[:, None] * y

    return rmsnorm(x, final_norm_w)
```

```cpp
#include <hip/hip_runtime.h>
#include <cstdio>
#include <cstdint>
#include <cmath>
namespace pg8 {
#define PG8_LAS __attribute__((address_space(3)))
typedef unsigned short bf16_t;
typedef short bf16x8 __attribute__((ext_vector_type(8)));
typedef float f32x4 __attribute__((ext_vector_type(4)));
typedef unsigned u32x4 __attribute__((ext_vector_type(4)));
constexpr int BM = 256, BK = 64, HALF = 128, HTB = HALF * BK * 2  , STAGE_BYTES = 8 * HTB, NXCD = 8, WGM = 8;

__host__ __device__ __forceinline__ int lds_byte(int r, int c) { const int st = (r >> 4) * 2 + (c >> 5), rr = r & 15, cc = c & 31, ob = rr * 64 + cc * 2; return st * 1024 + (ob ^ (((ob >> 9) & 1) << 5)); }
__host__ __device__ __forceinline__ void stage_rc(int b, int& R, int& C) { const int st = b / 1024, sb = b % 1024, swz = sb ^ (((sb >> 9) & 1) << 5); R = (st >> 1) * 16 + swz / 64; C = (st & 1) * 32 + (swz % 64) / 2; }
__host__ __device__ __forceinline__ int perm32(int rho) { const int n = rho >> 4, i = rho & 15; return 8 * (i >> 2) + 4 * n + (i & 3); }

struct Unit { int pm, pn; };
struct Gemm { const bf16_t* A; const bf16_t* Bt; int M, N, K; };

struct StaticOrder {
    int nM, nN, nwg, G, c;
    __host__ __device__ void init(int M, int N, int G_, int c_) { nM = M / BM; nN = N / BM; nwg = nM * nN; G = G_; c = c_; }
    __host__ __device__ bool next(int i, Unit& u) const {
        const long L = (long)i * G + c; if (L >= nwg) return false;
        int wgid = (int)L; { const int q = nwg / NXCD, r = nwg % NXCD, xcd = wgid % NXCD, off = wgid / NXCD; wgid = (xcd < r ? xcd * (q + 1) : r * (q + 1) + (xcd - r) * q) + off; }
        const int nig = WGM * nN, gid = wgid / nig, fm = gid * WGM, gsz = (nM - fm) < WGM ? (nM - fm) : WGM;
        u.pm = fm + ((wgid % nig) % gsz); u.pn = (wgid % nig) / gsz; return true;
    }
    __device__ __forceinline__ void a_ready(const Unit&) const {}
    __device__ __forceinline__ void done(const Unit&) const {}
};

__device__ __forceinline__ unsigned cvt_pk_bf16(float lo, float hi) { unsigned r; asm volatile("v_cvt_pk_bf16_f32 %0, %1, %2" : "=v"(r) : "v"(lo), "v"(hi)); return r; }

struct EpiU {
    static constexpr bool PERM = true, AFTER_DRAIN = false;
    bf16_t* U; int ldu; float* DT; int n_full;
    __device__ __forceinline__ void operator()(const f32x4 (&acc)[2][2][4][2], const Unit& u, int wr, int wc, int fr, int fq) const {
        const int row0 = u.pm * BM + wr * 64 + fr;
        if (u.pn < n_full) {
            const int col0 = u.pn * BM + wc * 32 + 8 * fq;
#pragma unroll
            for (int ai = 0; ai < 2; ++ai)
#pragma unroll
                for (int m = 0; m < 4; ++m) { bf16_t* rowp = U + (size_t)(row0 + ai * HALF + m * 16) * ldu + col0;
#pragma unroll
                    for (int bj = 0; bj < 2; ++bj) { const f32x4 v0 = acc[ai][bj][m][0], v1 = acc[ai][bj][m][1];
                        u32x4 w; w.x = cvt_pk_bf16(v0[0], v0[1]); w.y = cvt_pk_bf16(v0[2], v0[3]); w.z = cvt_pk_bf16(v1[0], v1[1]); w.w = cvt_pk_bf16(v1[2], v1[3]);
                        *(u32x4*)(rowp + bj * HALF) = w; } }
        } else if (wc == 0 && fq < 2) {
#pragma unroll
            for (int ai = 0; ai < 2; ++ai)
#pragma unroll
                for (int m = 0; m < 4; ++m) { float* rowp = DT + (size_t)(row0 + ai * HALF + m * 16) * 16 + 8 * fq;
                    *(f32x4*)(rowp) = acc[ai][0][m][0]; *(f32x4*)(rowp + 4) = acc[ai][0][m][1]; }
        }
    }
};
struct EpiResid {
    static constexpr bool PERM = false, AFTER_DRAIN = false;
    const float* base; float* out; int ldc; const float* gate; int gate_stride; int rows_per_batch;
    __device__ __forceinline__ void operator()(const f32x4 (&acc)[2][2][4][2], const Unit& u, int wr, int wc, int fr, int fq) const {
        const int row0 = u.pm * BM + wr * 64 + fr, col0 = u.pn * BM + wc * 32 + 4 * fq;
        const float* gp = gate + (size_t)((u.pm * BM) / rows_per_batch) * gate_stride + col0;
        f32x4 gv[2][2];
#pragma unroll
        for (int bj = 0; bj < 2; ++bj)
#pragma unroll
            for (int n = 0; n < 2; ++n) gv[bj][n] = *(const f32x4*)(gp + bj * HALF + n * 16);
#pragma unroll
        for (int ai = 0; ai < 2; ++ai)
#pragma unroll
            for (int m = 0; m < 4; ++m) { const size_t off = (size_t)(row0 + ai * HALF + m * 16) * ldc + col0;
#pragma unroll
                for (int bj = 0; bj < 2; ++bj)
#pragma unroll
                    for (int n = 0; n < 2; ++n) { const f32x4 bs = *(const f32x4*)(base + off + bj * HALF + n * 16);
                        *(f32x4*)(out + off + bj * HALF + n * 16) = bs + gv[bj][n] * acc[ai][bj][m][n]; } }
    }
};

template <class Epi, class Sched, bool ALIGN_EPI = false, bool SP2 = false>
__device__ __forceinline__ void gemm_phase(PG8_LAS unsigned char* lds, const Gemm g, const Sched& S, const Epi& E, const int tid) {
    const int wid = __builtin_amdgcn_readfirstlane(tid >> 6), lane = tid & 63, wr = wid >> 2, wc = wid & 3, fr = lane & 15, fq = lane >> 4;
    const int K = g.K, nt = K / BK;
    unsigned voffA[2], voffB[2];
#pragma unroll
    for (int i = 0; i < 2; ++i) { int R, C; stage_rc(tid * 16 + i * 8192, R, C); const int Rb = Epi::PERM ? ((R & ~31) + perm32(R & 31)) : R;
        voffA[i] = (unsigned)(R * K + C) * 2u; voffB[i] = (unsigned)(Rb * K + C) * 2u; }
    const size_t kstep = (size_t)(BK * 2);
    const size_t hstep = (size_t)HALF * K * 2;
    const size_t tstep = 2 * hstep;
    const unsigned ldsw = (unsigned)wid * 1024u;
    const int aoff = lds_byte(wr * 64 + fr, fq * 8), boff = lds_byte(wc * 32 + fr, fq * 8);
#define PG8_SA(b, h) (((b) * 2 + (h)) * HTB)
#define PG8_SB(b, h) ((4 + (b) * 2 + (h)) * HTB)
#define PG8_STAGE(bufoff, gbase, voff) do { _Pragma("unroll") for (int _i = 0; _i < 2; ++_i) \
        __builtin_amdgcn_global_load_lds((const unsigned*)((const char*)(gbase) + (voff)[_i]), (PG8_LAS unsigned*)(lds + (bufoff) + ldsw + _i * 8192), 16, 0, 0); } while (0)
#define PG8_LDA(dst, b, h) do { _Pragma("unroll") for (int m = 0; m < 4; ++m) _Pragma("unroll") for (int k = 0; k < 2; ++k) dst[m][k] = *(const PG8_LAS bf16x8*)(lds + PG8_SA(b, h) + aoff + m * 2048 + k * 1024); } while (0)
#define PG8_LDB(dst, b, h) do { _Pragma("unroll") for (int n = 0; n < 2; ++n) _Pragma("unroll") for (int k = 0; k < 2; ++k) dst[n][k] = *(const PG8_LAS bf16x8*)(lds + PG8_SB(b, h) + boff + n * 2048 + k * 1024); } while (0)
#define PG8_MMA(ai, bj, At, Bt) do { __builtin_amdgcn_s_setprio(1); _Pragma("unroll") for (int m = 0; m < 4; ++m) _Pragma("unroll") for (int n = 0; n < 2; ++n) _Pragma("unroll") for (int k = 0; k < 2; ++k) \
        acc[ai][bj][m][n] = __builtin_amdgcn_mfma_f32_16x16x32_bf16(Bt[n][k], At[m][k], acc[ai][bj][m][n], 0, 0, 0); __builtin_amdgcn_s_setprio(0); } while (0)
#define PG8_WAIT_V(n) asm volatile("s_waitcnt vmcnt(" #n ")" ::: "memory")
#define PG8_WAIT_L(n) asm volatile("s_waitcnt lgkmcnt(" #n ")" ::: "memory")
#define PG8_BAR __builtin_amdgcn_s_barrier()
#define PG8_SCHED __builtin_amdgcn_sched_barrier(0)
    Unit cur, nxt; int ui = 0;
    if (!S.next(0, cur)) return;
    f32x4 acc[2][2][4][2];
#pragma unroll
    for (int a = 0; a < 2; ++a)
#pragma unroll
        for (int b = 0; b < 2; ++b)
#pragma unroll
            for (int m = 0; m < 4; ++m)
#pragma unroll
                for (int n = 0; n < 2; ++n) acc[a][b][m][n] = (f32x4){0.f, 0.f, 0.f, 0.f};
    bf16x8 At[4][2], B0[2][2], B1[2][2];
    const char* cA = (const char*)g.A + (size_t)cur.pm * tstep; const char* cB = (const char*)g.Bt + (size_t)cur.pn * tstep;
    S.a_ready(cur);
    if constexpr (SP2) {
        PG8_STAGE(PG8_SB(0, 0), cB, voffB); PG8_STAGE(PG8_SB(0, 1), cB + hstep, voffB); PG8_STAGE(PG8_SA(0, 0), cA, voffA); PG8_STAGE(PG8_SA(0, 1), cA + hstep, voffA);
        if (wr == 1) PG8_BAR;
        PG8_WAIT_V(2); PG8_BAR;
        PG8_STAGE(PG8_SB(1, 0), cB + kstep, voffB); PG8_STAGE(PG8_SA(1, 0), cA + kstep, voffA); PG8_STAGE(PG8_SB(1, 1), cB + hstep + kstep, voffB);
        PG8_WAIT_V(6); PG8_BAR;
    } else {
        PG8_STAGE(PG8_SB(0, 0), cB, voffB); PG8_STAGE(PG8_SA(0, 0), cA, voffA); PG8_STAGE(PG8_SB(0, 1), cB + hstep, voffB); PG8_STAGE(PG8_SA(0, 1), cA + hstep, voffA);
        if (wr == 1) PG8_BAR;
        PG8_WAIT_V(4); PG8_BAR;
        PG8_STAGE(PG8_SB(1, 0), cB + kstep, voffB); PG8_STAGE(PG8_SA(1, 0), cA + kstep, voffA); PG8_STAGE(PG8_SB(1, 1), cB + hstep + kstep, voffB);
        PG8_WAIT_V(6); PG8_BAR;
    }
    for (;;) {
        const bool has_next = S.next(ui + 1, nxt);
        const char* nA = has_next ? (const char*)g.A + (size_t)nxt.pm * tstep : cA; const char* nB = has_next ? (const char*)g.Bt + (size_t)nxt.pn * tstep : cB;
        for (int t = 0; t < nt; t += 2) {
            const bool last = (t == nt - 2);
            const char* a1 = cA + (size_t)(t + 1) * kstep;
            const char* a2 = last ? nA : cA + (size_t)(t + 2) * kstep; const char* b2 = last ? nB : cB + (size_t)(t + 2) * kstep;
            const char* a3 = a2 + kstep; const char* b3 = b2 + kstep;
            if (last && has_next) S.a_ready(nxt);
            if constexpr (SP2) {
            PG8_LDB(B0, 0, 0); PG8_LDB(B1, 0, 1); PG8_SCHED; PG8_LDA(At, 0, 0); PG8_STAGE(PG8_SA(1, 1), a1 + hstep, voffA);
            PG8_WAIT_V(8); PG8_WAIT_L(0); PG8_BAR; PG8_MMA(0, 0, At, B0); PG8_MMA(0, 1, At, B1); PG8_BAR; PG8_SCHED;
            PG8_LDA(At, 0, 1); PG8_STAGE(PG8_SB(0, 0), b2, voffB); PG8_STAGE(PG8_SB(0, 1), b2 + hstep, voffB); PG8_STAGE(PG8_SA(0, 0), a2, voffA);
            PG8_WAIT_V(8); PG8_WAIT_L(0); PG8_BAR; PG8_MMA(1, 0, At, B0); PG8_MMA(1, 1, At, B1); PG8_BAR; PG8_SCHED;
            PG8_LDB(B0, 1, 0); PG8_LDB(B1, 1, 1); PG8_SCHED; PG8_LDA(At, 1, 0); PG8_STAGE(PG8_SA(0, 1), a2 + hstep, voffA);
            PG8_WAIT_V(8); PG8_WAIT_L(0); PG8_BAR; PG8_MMA(0, 0, At, B0); PG8_MMA(0, 1, At, B1); PG8_BAR; PG8_SCHED;
            PG8_LDA(At, 1, 1); PG8_STAGE(PG8_SB(1, 0), b3, voffB); PG8_STAGE(PG8_SB(1, 1), b3 + hstep, voffB); PG8_STAGE(PG8_SA(1, 0), a3, voffA);
            PG8_WAIT_V(8); PG8_WAIT_L(0); PG8_BAR; PG8_MMA(1, 0, At, B0); PG8_MMA(1, 1, At, B1); PG8_BAR; PG8_SCHED;
            } else {
            PG8_LDB(B0, 0, 0); PG8_SCHED; PG8_LDA(At, 0, 0); PG8_STAGE(PG8_SA(1, 1), a1 + hstep, voffA);
            PG8_WAIT_L(8); PG8_BAR; PG8_WAIT_L(0); PG8_MMA(0, 0, At, B0); PG8_BAR; PG8_SCHED;
            PG8_LDB(B1, 0, 1); PG8_STAGE(PG8_SB(0, 0), b2, voffB);
            PG8_BAR; PG8_WAIT_L(0); PG8_MMA(0, 1, At, B1); PG8_BAR;
            PG8_LDA(At, 0, 1); PG8_STAGE(PG8_SA(0, 0), a2, voffA);
            PG8_BAR; PG8_WAIT_L(0); PG8_MMA(1, 0, At, B0); PG8_BAR; PG8_SCHED;
            PG8_STAGE(PG8_SB(0, 1), b2 + hstep, voffB);
            PG8_WAIT_V(6); PG8_BAR; PG8_MMA(1, 1, At, B1); PG8_BAR;
            PG8_LDB(B0, 1, 0); PG8_SCHED; PG8_LDA(At, 1, 0); PG8_STAGE(PG8_SA(0, 1), a2 + hstep, voffA);
            PG8_WAIT_L(8); PG8_BAR; PG8_WAIT_L(0); PG8_MMA(0, 0, At, B0); PG8_BAR; PG8_SCHED;
            PG8_LDB(B1, 1, 1); PG8_STAGE(PG8_SB(1, 0), b3, voffB);
            PG8_BAR; PG8_WAIT_L(0); PG8_MMA(0, 1, At, B1); PG8_BAR;
            PG8_LDA(At, 1, 1); PG8_STAGE(PG8_SA(1, 0), a3, voffA);
            PG8_BAR; PG8_WAIT_L(0); PG8_MMA(1, 0, At, B0); PG8_BAR; PG8_SCHED;
            PG8_STAGE(PG8_SB(1, 1), b3 + hstep, voffB);
            PG8_WAIT_V(6); PG8_BAR; PG8_MMA(1, 1, At, B1); PG8_BAR;
            }
        }
        if constexpr (ALIGN_EPI) { if (wr == 0) PG8_BAR; }
        if constexpr (!Epi::AFTER_DRAIN) { E(acc, cur, wr, wc, fr, fq); S.done(cur); }
        if (!has_next) break;
#pragma unroll
        for (int a = 0; a < 2; ++a)
#pragma unroll
            for (int b = 0; b < 2; ++b)
#pragma unroll
                for (int m = 0; m < 4; ++m)
#pragma unroll
                    for (int n = 0; n < 2; ++n) acc[a][b][m][n] = (f32x4){0.f, 0.f, 0.f, 0.f};
        cur = nxt; cA = nA; cB = nB; ++ui;
        if constexpr (ALIGN_EPI) { if (wr == 1) PG8_BAR; }
    }
    PG8_WAIT_V(0);
    if constexpr (!ALIGN_EPI) { if (wr == 0) PG8_BAR; }
    PG8_BAR;
    if constexpr (Epi::AFTER_DRAIN) { E.fused(acc, cur, wr, wc, fr, fq, lds, wid, lane); S.done(cur); }
#undef PG8_SA
#undef PG8_SB
#undef PG8_STAGE
#undef PG8_LDA
#undef PG8_LDB
#undef PG8_MMA
#undef PG8_WAIT_V
#undef PG8_WAIT_L
#undef PG8_BAR
#undef PG8_SCHED
}
}
constexpr int NWAVES = 8, NTHREADS = 512;
constexpr int BATCH = 8, SEQ = 2048, DM = 1024, DEPTH = 4, M = BATCH * SEQ;
constexpr int NIN = 5648, NU = 5632, NIN_PAD = 5888, DIN = 2048;
constexpr int C_AX = 0, C_AG = 512, C_HQ = 1024, C_HF = 1536, C_HI = 2048, C_HG = 2560, C_Z = 3072, C_XBC = 4096, C_B = 5120, C_C = 5376;
constexpr int Y_A = 0, Y_B = 512, Y_C = 1024;
constexpr float EPS = 1e-6f;
constexpr int NSSQ = 32;

constexpr size_t MiB = 1u << 20;
constexpr size_t WS_CTL = 0, CTL_ZERO_BYTES = 1 * MiB;
constexpr size_t WS_WIN = 2 * MiB;
constexpr size_t WS_WOUT = 48 * MiB;
constexpr size_t WS_MOD = 64 * MiB;
constexpr size_t WS_DT = 65 * MiB;
constexpr size_t WS_SSQ = 66 * MiB;
constexpr size_t WS_H = 68 * MiB;
constexpr size_t WS_Y = 100 * MiB;
constexpr size_t WS_U = 164 * MiB;
constexpr size_t WS_END = 340 * MiB;
static_assert(WS_WIN + (size_t)DEPTH * NIN_PAD * DM * 2 <= WS_WOUT && WS_WOUT + (size_t)DEPTH * DM * DIN * 2 <= WS_MOD && WS_U + (size_t)M * NU * 2 <= WS_END, "d_ws map");
constexpr int CW_BAR = 4096;

constexpr int RING_OFF = 0, RING_BYTES = 131072;
constexpr int LDSCTL_OFF = RING_BYTES, MISC_OFF = LDSCTL_OFF + 320;
constexpr int LDS_BYTES = 147456;

#define GAS __attribute__((address_space(1)))
#define LAS __attribute__((address_space(3)))
typedef unsigned short bf16;
typedef unsigned v4u __attribute__((ext_vector_type(4)));
typedef float f32x4 __attribute__((ext_vector_type(4)));
typedef short bf16x8 __attribute__((ext_vector_type(8)));
typedef GAS unsigned gu32;
typedef GAS unsigned long long gu64;
#define RLX_AGENT __ATOMIC_RELAXED, __HIP_MEMORY_SCOPE_AGENT
#define LDS_WAIT() asm volatile("s_waitcnt lgkmcnt(0)" ::: "memory")
#define VM_WAIT() asm volatile("s_waitcnt vmcnt(0)" ::: "memory")
__device__ __forceinline__ unsigned long long rt() { return __builtin_amdgcn_s_memrealtime(); }
__device__ __forceinline__ unsigned f2bf(float f) { unsigned u = __builtin_bit_cast(unsigned, f); return (u + 0x7fffu + ((u >> 16) & 1u)) >> 16; }
__device__ __forceinline__ unsigned pk2(float lo, float hi) { return f2bf(lo) | (f2bf(hi) << 16); }

#define XB_TMO      128
#define XB_XCNT(j)  (256  + 64 * (j))
#define XB_XSUB(j)  (1280 + 64 * (j))
#define XB_XGEN(j)  (2304 + 64 * (j))
#define XB_TOP      3328
#define XB_TOPGEN   3392
#define XCD_BAR_WORDS 3456
#define XB_SPIN_CAP (1u << 18)

__device__ __forceinline__ unsigned xb_ld(unsigned* p)              { return __hip_atomic_load(p, __ATOMIC_RELAXED, __HIP_MEMORY_SCOPE_AGENT); }
__device__ __forceinline__ unsigned xb_add(unsigned* p, unsigned v) { return __hip_atomic_fetch_add(p, v, __ATOMIC_RELAXED, __HIP_MEMORY_SCOPE_AGENT); }
__device__ __forceinline__ unsigned xb_xcc_id() { return (unsigned)__builtin_amdgcn_s_getreg((3 << 11) | 20) & 0xFu; }
#define XB_SPIN(cond, bar) do { unsigned _sp = 0; while (cond) { __builtin_amdgcn_s_sleep(1); \
    if ((++_sp & 255u) == 0u) { if (xb_ld(&(bar)[XB_TMO])) break; if (_sp > XB_SPIN_CAP) { atomicAdd(&(bar)[XB_TMO], 1u); break; } } } } while (0)

struct XcdBarrier {
    unsigned* bar; unsigned x;
    volatile LAS unsigned* st;
};

__device__ __forceinline__ XcdBarrier xcd_barrier_post(unsigned* bar, volatile LAS unsigned* st) {
    XcdBarrier b; b.bar = bar; b.x = xb_xcc_id(); b.st = st;
    if (threadIdx.x == 0) (void)xb_add(&bar[XB_XCNT(b.x)], 1u);
    return b;
}
__device__ __forceinline__ void xcd_barrier_complete(unsigned* bar, unsigned x, unsigned& nloc, unsigned& nx) {
    const unsigned G = gridDim.x * gridDim.y * gridDim.z;
    unsigned sum, cnt, mine, sp = 0u;
    for (;;) {
        sum = 0u; cnt = 0u; mine = 0u;
#pragma unroll
        for (unsigned j = 0; j < 16; ++j) { const unsigned c = xb_ld(&bar[XB_XCNT(j)]); sum += c; cnt += (c > 0u) ? 1u : 0u; mine = (j == x) ? c : mine; }
        if (sum == G) break;
        __builtin_amdgcn_s_sleep(1);
        if ((++sp & 255u) == 0u) { if (xb_ld(&bar[XB_TMO])) break; if (sp > XB_SPIN_CAP) { atomicAdd(&bar[XB_TMO], 1u); break; } }
    }
    nloc = mine > 0u ? mine : 1u; nx = cnt > 0u ? cnt : 1u;
}

__device__ __forceinline__ void xcd_barrier(const XcdBarrier& b) {
    asm volatile("s_waitcnt vmcnt(0)" ::: "memory");
    __syncthreads();
    if (threadIdx.x == 0) {
        unsigned* bar = b.bar;
        __builtin_amdgcn_s_waitcnt(0);
        unsigned nloc = b.st[0], nx = b.st[1];
        if (nloc == 0u) { xcd_barrier_complete(bar, b.x, nloc, nx); b.st[0] = nloc; b.st[1] = nx; }
        const unsigned old = xb_add(&bar[XB_XSUB(b.x)], 1u);
        const unsigned gen = old / nloc;
        if (old + 1u == (gen + 1u) * nloc) {
            __builtin_amdgcn_fence(__ATOMIC_RELEASE, "agent");
            asm volatile("s_waitcnt vmcnt(0)" ::: "memory");
            const unsigned og = xb_add(&bar[XB_TOP], 1u);
            const unsigned tg = og / nx;
            if (og + 1u == (tg + 1u) * nx) xb_add(&bar[XB_TOPGEN], 1u);
            else XB_SPIN(xb_ld(&bar[XB_TOPGEN]) == tg, bar);
            __builtin_amdgcn_fence(__ATOMIC_ACQUIRE, "agent");
            xb_add(&bar[XB_XGEN(b.x)], 1u);
            asm volatile("s_waitcnt vmcnt(0)" ::: "memory");
        } else {
            XB_SPIN(xb_ld(&bar[XB_XGEN(b.x)]) == gen, bar);
            __builtin_amdgcn_fence(__ATOMIC_ACQUIRE, "agent");
            asm volatile("s_waitcnt vmcnt(0)" ::: "memory");
        }
    }
    __syncthreads();
}
struct Frame {
    LAS unsigned char* lds;
    int tid, lane, wave;
    int vcu, G, bx;
};
struct Args { const float* in[23]; float* out; unsigned char* ws; int ph_lo, ph_hi; };
typedef const __attribute__((address_space(4))) Args* KA;
#define P_WIN  ((bf16*)(A->ws + WS_WIN))
#define P_WOUT ((bf16*)(A->ws + WS_WOUT))
#define P_H    ((bf16*)(A->ws + WS_H))
#define P_Y    ((bf16*)(A->ws + WS_Y))
#define P_U    ((bf16*)(A->ws + WS_U))
#define P_MOD  ((float*)(A->ws + WS_MOD))
#define P_DT   ((float*)(A->ws + WS_DT))
#define P_SSQ  ((float*)(A->ws + WS_SSQ))
enum { I_X = 0, I_C, I_NORMW, I_WADA, I_BADA, I_WIN, I_LCW, I_LCB, I_LWA, I_LBA, I_LWX, I_LBX, I_LLAM, I_HGLB, I_HGNW, I_SCW, I_SCB, I_SDTB, I_SALOG, I_SD, I_SNW, I_WOUT, I_FNW };

__device__ __forceinline__ float bf2f(bf16 h) { return __uint_as_float((unsigned)h << 16); }
__device__ __forceinline__ float sigmoidf_(float x) { return 1.0f / (1.0f + __expf(-x)); }
__device__ __forceinline__ float siluf_(float x) { return x * sigmoidf_(x); }
__device__ __forceinline__ float softplusf_(float x) { return x > 20.f ? x : log1pf(__expf(x)); }
__device__ __forceinline__ float wave_sum(float v) {
#pragma unroll
    for (int o = 1; o < 64; o <<= 1) v += __shfl_xor(v, o);
    return v;
}

__device__ __forceinline__ void p0_transpose_item(const float* W, int K, int N, bf16* WT, LAS float* scr, int item, int lane) {
    const int nblk = (N + 31) / 32, kb = item / nblk, nb = item % nblk, k0 = 64 * kb, n0 = 32 * nb;
    const int nn = n0 + (lane & 31); const bool okc = nn < N;
#pragma unroll 8
    for (int i = 0; i < 32; ++i) { const int kk = 2 * i + (lane >> 5); scr[kk * 33 + (lane & 31)] = okc ? W[(size_t)(k0 + kk) * N + nn] : 0.f; }
    LDS_WAIT(); asm volatile("" ::: "memory");
    const int c = lane & 7;
#pragma unroll
    for (int j = 0; j < 4; ++j) { const int n = (lane >> 3) + 8 * j; const LAS float* s = scr + (8 * c) * 33 + n;
        v4u o; o.x = pk2(s[0 * 33], s[1 * 33]); o.y = pk2(s[2 * 33], s[3 * 33]); o.z = pk2(s[4 * 33], s[5 * 33]); o.w = pk2(s[6 * 33], s[7 * 33]);
        *(GAS v4u*)(WT + (size_t)(n0 + n) * K + k0 + 8 * c) = o; }
    LDS_WAIT(); asm volatile("" ::: "memory");
}

__device__ __forceinline__ void p0_prologue(Frame& F, KA A) {
    {
        LAS float* scr = (LAS float*)(F.lds + RING_OFF + F.wave * 16384);
        const int gw = F.vcu * NWAVES + F.wave, NGW = F.G * NWAVES;
        constexpr int I_IN = (DM / 64) * ((NIN + 31) / 32), I_OUT = (DIN / 64) * (DM / 32), I_ZERO = (NIN_PAD - 5664) * DM * 2 / 1024;
        constexpr int PER_L = I_IN + I_OUT + I_ZERO, NITEMS = DEPTH * PER_L;
        for (int it = gw; it < NITEMS; it += NGW) {
            const int l = it / PER_L; int r = it % PER_L;
            bf16* win = P_WIN + (size_t)l * NIN_PAD * DM; bf16* wout = P_WOUT + (size_t)l * DM * DIN;
            if (r < I_IN) { p0_transpose_item(A->in[I_WIN] + (size_t)l * DM * NIN, DM, NIN, win, scr, r, F.lane); continue; } r -= I_IN;
            if (r < I_OUT) { p0_transpose_item(A->in[I_WOUT] + (size_t)l * DIN * DM, DIN, DM, wout, scr, r, F.lane); continue; } r -= I_OUT;
            *(GAS v4u*)((unsigned char*)(win + (size_t)5664 * DM) + (size_t)r * 1024 + F.lane * 16) = (v4u){0u, 0u, 0u, 0u};
        }
    }
    __syncthreads();
    {
        LAS float* part = (LAS float*)(F.lds + RING_OFF);
        const float* cc = A->in[I_C];
        for (int un = F.vcu; un < DEPTH * 48; un += F.G) {
            const int l = un / 48, n0 = (un % 48) * 64;
            const float* w = A->in[I_WADA] + (size_t)l * DM * 3 * DM + n0 + F.lane;
            float acc[8];
#pragma unroll
            for (int b = 0; b < 8; ++b) acc[b] = 0.f;
            for (int k = F.wave * 128; k < F.wave * 128 + 128; ++k) {
                const float wv = w[(size_t)k * 3 * DM];
#pragma unroll
                for (int b = 0; b < 8; ++b) { const float cv = cc[b * DM + k]; acc[b] += siluf_(cv) * wv; }
            }
#pragma unroll
            for (int b = 0; b < 8; ++b) part[(F.wave * 8 + b) * 64 + F.lane] = acc[b];
            __syncthreads();
            { const int b = F.wave; float s = 0.f;
#pragma unroll
              for (int w8 = 0; w8 < 8; ++w8) s += part[(w8 * 8 + b) * 64 + F.lane];
              P_MOD[((size_t)l * BATCH + b) * 3 * DM + n0 + F.lane] = s + A->in[I_BADA][(size_t)l * 3 * DM + n0 + F.lane]; }
            __syncthreads();
        }
    }
}

__device__ __forceinline__ void norm_phase(Frame& F, KA A, const float* xsrc, int l) {
    const int gw = F.vcu * NWAVES + F.wave, NGW = F.G * NWAVES;
    const float* nw = A->in[I_NORMW] + (size_t)l * DM;
    for (int m = gw; m < M; m += NGW) {
        const int b = m / SEQ;
        const float* shift = P_MOD + ((size_t)l * BATCH + b) * 3 * DM; const float* scale = shift + DM;
        const GAS f32x4* xr = (const GAS f32x4*)(xsrc + (size_t)m * DM) + F.lane;
        f32x4 v[4]; float s = 0.f;
#pragma unroll
        for (int j = 0; j < 4; ++j) { v[j] = xr[64 * j]; s += (v[j].x * v[j].x + v[j].y * v[j].y) + (v[j].z * v[j].z + v[j].w * v[j].w); }
        const float inv = 1.0f / sqrtf(wave_sum(s) * (1.f / DM) + EPS);
        GAS unsigned long long* o8 = (GAS unsigned long long*)(P_H + (size_t)m * DM) + F.lane;
#pragma unroll
        for (int j = 0; j < 4; ++j) { const int k = 4 * F.lane + 256 * j;
            const f32x4 w4 = *(const f32x4*)(nw + k), sc = *(const f32x4*)(scale + k), sh = *(const f32x4*)(shift + k);
            const f32x4 hv = (v[j] * inv) * w4 * (sc + 1.0f) + sh;
            o8[64 * j] = (unsigned long long)pk2(hv.x, hv.y) | ((unsigned long long)pk2(hv.z, hv.w) << 32); }
    }
}
__device__ __forceinline__ void final_norm_phase(Frame& F, KA A) {
    const int gw = F.vcu * NWAVES + F.wave, NGW = F.G * NWAVES;
    const float* nw = A->in[I_FNW];
    for (int m = gw; m < M; m += NGW) {
        GAS f32x4* xr = (GAS f32x4*)(A->out + (size_t)m * DM) + F.lane;
        f32x4 v[4]; float s = 0.f;
#pragma unroll
        for (int j = 0; j < 4; ++j) { v[j] = xr[64 * j]; s += (v[j].x * v[j].x + v[j].y * v[j].y) + (v[j].z * v[j].z + v[j].w * v[j].w); }
        const float inv = 1.0f / sqrtf(wave_sum(s) * (1.f / DM) + EPS);
#pragma unroll
        for (int j = 0; j < 4; ++j) { const f32x4 w4 = *(const f32x4*)(nw + 4 * F.lane + 256 * j); xr[64 * j] = (v[j] * inv) * w4; }
    }
}
__device__ __forceinline__ void ynorm_phase(Frame& F, KA A) {
    const int gw = F.vcu * NWAVES + F.wave, NGW = F.G * NWAVES;
    for (int m = gw; m < M; m += NGW) {
        const float* sq = P_SSQ + (size_t)m * NSSQ;
        float sc[3];
        sc[0] = 1.0f / sqrtf(((sq[16] + sq[17]) + (sq[18] + sq[19])) * (1.f / 512.f) + EPS);
#pragma unroll
        for (int g = 0; g < 2; ++g) { float s = 0.f;
#pragma unroll
            for (int j = 0; j < 8; ++j) s += sq[8 * g + j];
            sc[1 + g] = 1.0f / sqrtf(s * (1.f / 512.f) + EPS); }
        GAS v4u* yr = (GAS v4u*)(P_Y + (size_t)m * DIN + Y_B) + F.lane;
#pragma unroll
        for (int s3 = 0; s3 < 3; ++s3) { v4u w = yr[64 * s3]; const float f = sc[s3];
            w.x = pk2(__uint_as_float(w.x << 16) * f, __uint_as_float(w.x & 0xffff0000u) * f);
            w.y = pk2(__uint_as_float(w.y << 16) * f, __uint_as_float(w.y & 0xffff0000u) * f);
            w.z = pk2(__uint_as_float(w.z << 16) * f, __uint_as_float(w.z & 0xffff0000u) * f);
            w.w = pk2(__uint_as_float(w.w << 16) * f, __uint_as_float(w.w & 0xffff0000u) * f);
            yr[64 * s3] = w; }
    }
}
__device__ __forceinline__ void lru_unit(Frame& F, KA A, int l, int b, int hd) {
    LAS float* WA = (LAS float*)(F.lds + RING_OFF);
    LAS float* WX = WA + 4096;
    LAS float* XA = WX + 4096;
    LAS float* AA = XA + 64 * 65;
    LAS float* BB = AA + 4096;
    const int tid = F.tid, lane = F.lane, wave = F.wave;
    const int c0 = hd * 64;
    { const float* wa = A->in[I_LWA] + (size_t)(l * 8 + hd) * 4096; const float* wx = A->in[I_LWX] + (size_t)(l * 8 + hd) * 4096;
      for (int i = tid; i < 4096; i += NTHREADS) { WA[i] = wa[i]; WX[i] = wx[i]; } }
    const int j = tid & 63;
    float cw[4];
#pragma unroll
    for (int k = 0; k < 4; ++k) cw[k] = A->in[I_LCW][(size_t)(l * 4 + k) * 512 + c0 + j];
    const float cbias = A->in[I_LCB][(size_t)l * 512 + c0 + j];
    const int gt = tid >> 3, jg = tid & 7;
    float ba[8], bx[8], sp[8];
#pragma unroll
    for (int q = 0; q < 8; ++q) { const int ch = c0 + jg * 8 + q; ba[q] = A->in[I_LBA][(size_t)l * 512 + ch]; bx[q] = A->in[I_LBX][(size_t)l * 512 + ch]; sp[q] = softplusf_(-A->in[I_LLAM][(size_t)l * 512 + ch]); }
    float hcar = 0.f;
    const bf16* Ub = P_U + (size_t)b * SEQ * NU;
    bf16* Yb = P_Y + (size_t)b * SEQ * DIN;
    __syncthreads();
    for (int tile = 0; tile < SEQ / 64; ++tile) {
        const int t0 = tile * 64;
#pragma unroll
        for (int r = 0; r < 8; ++r) { const int tt = (tid >> 6) + 8 * r, t = t0 + tt; float a = cbias;
#pragma unroll
            for (int k = 0; k < 4; ++k) { const int ts = t - 3 + k; if (ts >= 0) a += cw[k] * bf2f(Ub[(size_t)ts * NU + C_AX + c0 + j]); }
            XA[tt * 65 + j] = a; }
        __syncthreads();
        { float ra[8], ia[8];
#pragma unroll
          for (int q = 0; q < 8; ++q) { ra[q] = ba[q]; ia[q] = bx[q]; }
          for (int i = 0; i < 64; ++i) { const float xv = XA[gt * 65 + i];
#pragma unroll
              for (int q = 0; q < 8; ++q) { ra[q] += xv * WA[i * 64 + jg * 8 + q]; ia[q] += xv * WX[i * 64 + jg * 8 + q]; } }
#pragma unroll
          for (int q = 0; q < 8; ++q) { const float rg = sigmoidf_(ra[q]), ig = sigmoidf_(ia[q]); const float la = -8.0f * rg * sp[q]; const float a = __expf(la);
              const float mult = sqrtf(fmaxf(-expm1f(2.0f * la), 0.f)); const float xv = XA[gt * 65 + jg * 8 + q];
              AA[gt * 64 + jg * 8 + q] = a; BB[gt * 64 + jg * 8 + q] = mult * (ig * xv); } }
        __syncthreads();
        if (wave == 0) { for (int tt = 0; tt < 64; ++tt) { hcar = AA[tt * 64 + lane] * hcar + BB[tt * 64 + lane]; AA[tt * 64 + lane] = hcar; } }
        __syncthreads();
#pragma unroll
        for (int r = 0; r < 8; ++r) { const int tt = (tid >> 6) + 8 * r, t = t0 + tt; const float g = bf2f(Ub[(size_t)t * NU + C_AG + c0 + j]);
            Yb[(size_t)t * DIN + Y_A + c0 + j] = (bf16)f2bf(AA[tt * 64 + j] * siluf_(g)); }
        __syncthreads();
    }
}
__device__ __forceinline__ void hgrn_unit_naive(Frame& F, KA A, int l, int b, int h) {
    LAS float* QS = (LAS float*)(F.lds + RING_OFF);
    LAS float* FS = QS + 4096; LAS float* KS = FS + 4096; LAS float* VS = KS + 4096; LAS float* OP = VS + 4096;
    const int tid = F.tid, lane = F.lane, wave = F.wave;
    const int d = tid & 127, c = h * 128 + d, dq = tid >> 7;
    float lb;
    { float lg[4], mx = -1e30f;
#pragma unroll
      for (int q = 0; q < 4; ++q) { lg[q] = A->in[I_HGLB][(size_t)q * 512 + c]; mx = fmaxf(mx, lg[q]); }
      float sum = 0.f;
#pragma unroll
      for (int q = 0; q < 4; ++q) { lg[q] = __expf(lg[q] - mx); sum += lg[q]; }
      lb = 0.f;
#pragma unroll
      for (int q = 1; q < 4; ++q) if (q <= l) lb += lg[q] / sum; }
    float S[32];
#pragma unroll
    for (int i = 0; i < 32; ++i) S[i] = 0.f;
    const bf16* Ub = P_U + (size_t)b * SEQ * NU;
    bf16* Yb = P_Y + (size_t)b * SEQ * DIN;
    const float nw0 = A->in[I_HGNW][(size_t)l * 512 + h * 128 + lane], nw1 = A->in[I_HGNW][(size_t)l * 512 + h * 128 + lane + 64];
    for (int tile = 0; tile < SEQ / 32; ++tile) {
        const int t0 = tile * 32;
#pragma unroll
        for (int r = 0; r < 8; ++r) { const int tt = (tid >> 7) + 4 * r; const bf16* ur = Ub + (size_t)(t0 + tt) * NU;
            const float q = bf2f(ur[C_HQ + c]), hf = bf2f(ur[C_HF + c]), vi = bf2f(ur[C_HI + c]);
            const float sg = sigmoidf_(hf);
            QS[tt * 128 + d] = siluf_(q); FS[tt * 128 + d] = lb + (1.f - lb) * sg; KS[tt * 128 + d] = (1.f - lb) * (1.f - sg); VS[tt * 128 + d] = vi; }
        __syncthreads();
        for (int tt = 0; tt < 32; ++tt) { const float vv = VS[tt * 128 + d]; float part = 0.f;
#pragma unroll
            for (int dd = 0; dd < 32; ++dd) { const int di = tt * 128 + dq * 32 + dd; S[dd] = FS[di] * S[dd] + KS[di] * vv; part += QS[di] * S[dd]; }
            OP[(dq * 32 + tt) * 128 + d] = part; }
        __syncthreads();
#pragma unroll
        for (int q4 = 0; q4 < 4; ++q4) { const int tt = 4 * wave + q4; const size_t t = t0 + tt;
            float o0 = 0.f, o1 = 0.f;
#pragma unroll
            for (int q = 0; q < 4; ++q) { o0 += OP[(q * 32 + tt) * 128 + lane]; o1 += OP[(q * 32 + tt) * 128 + lane + 64]; }
            const float ssq = wave_sum(o0 * o0 + o1 * o1);
            const float g0 = bf2f(Ub[t * NU + C_HG + h * 128 + lane]), g1 = bf2f(Ub[t * NU + C_HG + h * 128 + lane + 64]);
            Yb[t * DIN + Y_B + h * 128 + lane] = (bf16)f2bf(o0 * nw0 * siluf_(g0)); Yb[t * DIN + Y_B + h * 128 + lane + 64] = (bf16)f2bf(o1 * nw1 * siluf_(g1));
            if (lane == 0) P_SSQ[((size_t)b * SEQ + t) * NSSQ + 16 + h] = ssq; }
        __syncthreads();
    }
}
__device__ __forceinline__ void ssd_unit_naive(Frame& F, KA A, int l, int b, int hh) {
    LAS float* BS = (LAS float*)(F.lds + RING_OFF);
    LAS float* CS = BS + 4096; LAS float* XS = CS + 4096; LAS float* DTS = XS + 2048; LAS float* DAS = DTS + 32; LAS float* YP = DAS + 32;
    const int tid = F.tid, lane = F.lane, wave = F.wave;
    const int g = hh >> 3, n = tid & 127, p = tid & 63, nq = tid >> 6;
    const float* cwp = A->in[I_SCW] + (size_t)l * 4 * 1536; const float* cbp = A->in[I_SCB] + (size_t)l * 1536;
    const int chB = 1024 + g * 128 + n, chC = 1280 + g * 128 + n, chX = hh * 64 + p;
    float wB[4], wC[4], wX[4];
#pragma unroll
    for (int k = 0; k < 4; ++k) { wB[k] = cwp[k * 1536 + chB]; wC[k] = cwp[k * 1536 + chC]; wX[k] = cwp[k * 1536 + chX]; }
    const float bB = cbp[chB], bC = cbp[chC], bX = cbp[chX];
    const float Ah = -__expf(A->in[I_SALOG][l * 16 + hh]), dtb = A->in[I_SDTB][l * 16 + hh], Dh = A->in[I_SD][l * 16 + hh];
    const float nwv = A->in[I_SNW][(size_t)l * 1024 + hh * 64 + lane];
    float S[16];
#pragma unroll
    for (int i = 0; i < 16; ++i) S[i] = 0.f;
    const bf16* Ub = P_U + (size_t)b * SEQ * NU;
    bf16* Yb = P_Y + (size_t)b * SEQ * DIN;
    for (int tile = 0; tile < SEQ / 32; ++tile) {
        const int t0 = tile * 32;
#pragma unroll
        for (int r = 0; r < 8; ++r) { const int tt = (tid >> 7) + 4 * r, t = t0 + tt; float ab = bB, ac = bC;
#pragma unroll
            for (int k = 0; k < 4; ++k) { const int ts = t - 3 + k; if (ts >= 0) { ab += wB[k] * bf2f(Ub[(size_t)ts * NU + C_XBC + chB]); ac += wC[k] * bf2f(Ub[(size_t)ts * NU + C_XBC + chC]); } }
            BS[tt * 128 + n] = siluf_(ab); CS[tt * 128 + n] = siluf_(ac); }
#pragma unroll
        for (int r = 0; r < 4; ++r) { const int tt = (tid >> 6) + 8 * r, t = t0 + tt; float ax = bX;
#pragma unroll
            for (int k = 0; k < 4; ++k) { const int ts = t - 3 + k; if (ts >= 0) ax += wX[k] * bf2f(Ub[(size_t)ts * NU + C_XBC + chX]); }
            XS[tt * 64 + p] = siluf_(ax); }
        if (tid < 32) { const float dtv = softplusf_(P_DT[((size_t)b * SEQ + t0 + tid) * 16 + hh] + dtb); DTS[tid] = dtv; DAS[tid] = __expf(dtv * Ah); }
        __syncthreads();
        for (int tt = 0; tt < 32; ++tt) { const float xdt = XS[tt * 64 + p] * DTS[tt], dec = DAS[tt]; float part = 0.f;
#pragma unroll
            for (int nn = 0; nn < 16; ++nn) { const int ni = tt * 128 + nq * 16 + nn; S[nn] = dec * S[nn] + xdt * BS[ni]; part += CS[ni] * S[nn]; }
            YP[(nq * 32 + tt) * 64 + p] = part; }
        __syncthreads();
#pragma unroll
        for (int q4 = 0; q4 < 4; ++q4) { const int tt = 4 * wave + q4; const size_t t = t0 + tt;
            float y = 0.f;
#pragma unroll
            for (int q = 0; q < 8; ++q) y += YP[(q * 32 + tt) * 64 + lane];
            const float z = bf2f(Ub[t * NU + C_Z + hh * 64 + lane]);
            const float v = (y + Dh * XS[tt * 64 + lane]) * siluf_(z);
            const float ssq = wave_sum(v * v);
            Yb[t * DIN + Y_C + hh * 64 + lane] = (bf16)f2bf(v * nwv);
            if (lane == 0) P_SSQ[((size_t)b * SEQ + t) * NSSQ + hh] = ssq; }
        __syncthreads();
    }
}
__device__ __forceinline__ void mixer_phase(Frame& F, KA A, int l) {
    for (int un = F.vcu; un < 224; un += F.G) {
        if (un < 128) ssd_unit_naive(F, A, l, un >> 4, un & 15);
        else if (un < 192) lru_unit(F, A, l, (un - 128) >> 3, (un - 128) & 7);
        else hgrn_unit_naive(F, A, l, (un - 192) >> 2, (un - 192) & 3);
        __syncthreads();
    }
}
constexpr int NPHASES = 2 + 5 * DEPTH;
#ifndef MK_ONE_LAUNCH
#define MK_ONE_LAUNCH 1
#endif
__global__ void __launch_bounds__(NTHREADS, 2) hybrid_fwd(Args args) {
    extern __shared__ __attribute__((aligned(16))) unsigned char lds[];
    const KA Ak = (KA)__builtin_amdgcn_kernarg_segment_ptr();
    for (int u = threadIdx.x; u < (LDS_BYTES - LDSCTL_OFF) / 4; u += NTHREADS) ((LAS unsigned*)((LAS unsigned char*)lds + LDSCTL_OFF))[u] = 0u;
    __syncthreads();
    const int lo = Ak->ph_lo, hi = Ak->ph_hi;
    XcdBarrier bar; bar.bar = (unsigned*)(Ak->ws + WS_CTL) + CW_BAR; bar.x = 0; bar.st = nullptr;
    if (hi - lo > 1) bar = xcd_barrier_post((unsigned*)(Ak->ws + WS_CTL) + CW_BAR, (volatile LAS unsigned*)((LAS unsigned char*)lds + MISC_OFF) + 8);

    for (int ph = lo; ph < hi; ++ph) {
        KA A = Ak; asm volatile("" : "+s"(A));
        Frame F;
        { int tid = threadIdx.x; asm volatile("" : "+v"(tid)); F.tid = tid; F.lane = tid & 63; F.wave = __builtin_amdgcn_readfirstlane(tid >> 6); }
        { int G = gridDim.x, bx = blockIdx.x; asm volatile("" : "+s"(G), "+s"(bx)); F.G = G; F.bx = bx; F.vcu = (G % 8 == 0) ? (bx % 8) * (G / 8) + bx / 8 : bx; }
        { unsigned lb = 0; asm volatile("" : "+s"(lb)); F.lds = (LAS unsigned char*)lds + lb; }
        if (ph == 0) p0_prologue(F, A);
        else if (ph == 1) norm_phase(F, A, A->in[I_X], 0);
        else {
            const int l = (ph - 2) / 5, sub = (ph - 2) % 5;
            if (sub == 0) {
                pg8::Gemm g{P_H, P_WIN + (size_t)l * NIN_PAD * DM, M, NIN_PAD, DM}; pg8::StaticOrder S; S.init(M, NIN_PAD, F.G, F.bx);
                pg8::EpiU E{P_U, NU, P_DT, NU / 256};
                pg8::gemm_phase<pg8::EpiU, pg8::StaticOrder, true, true>(F.lds + RING_OFF, g, S, E, F.tid);
            } else if (sub == 1) {
                mixer_phase(F, A, l);
            } else if (sub == 2) {
                ynorm_phase(F, A);
            } else if (sub == 3) {
                pg8::Gemm g{P_Y, P_WOUT + (size_t)l * DM * DIN, M, DM, DIN}; pg8::StaticOrder S; S.init(M, DM, F.G, F.bx);
                pg8::EpiResid E{l == 0 ? A->in[I_X] : A->out, A->out, DM, P_MOD + (size_t)l * BATCH * 3 * DM + 2 * DM, 3 * DM, SEQ};
                pg8::gemm_phase<pg8::EpiResid, pg8::StaticOrder, true, true>(F.lds + RING_OFF, g, S, E, F.tid);
            } else {
                if (l + 1 < DEPTH) norm_phase(F, A, A->out, l + 1); else final_norm_phase(F, A);
            }
        }
        if (ph + 1 < hi) xcd_barrier(bar);
    }
}

extern "C" void kernel_launch(void* const* d_in, const int* in_sizes, int n_in, void* d_out, int out_size, void* d_ws, size_t ws_size, hipStream_t stream) {
    static int grid = 0;
    if (grid == 0) {
        if (n_in != 23 || in_sizes[0] != M * DM || out_size != M * DM || ws_size < WS_END) { fprintf(stderr, "kernel_launch: unexpected shapes: n_in %d in0 %d out %d ws %zu (need %zu)\n", n_in, n_in > 0 ? in_sizes[0] : -1, out_size, ws_size, (size_t)WS_END); grid = -1; return; }
        int dev = 0, cus = 0, per_cu = 0;
        if (hipGetDevice(&dev) != hipSuccess || hipDeviceGetAttribute(&cus, hipDeviceAttributeMultiprocessorCount, dev) != hipSuccess) { grid = -1; return; }
        if (hipFuncSetAttribute((const void*)hybrid_fwd, hipFuncAttributeMaxDynamicSharedMemorySize, LDS_BYTES) != hipSuccess) { fprintf(stderr, "kernel_launch: hipFuncSetAttribute failed\n"); grid = -1; return; }
        if (hipOccupancyMaxActiveBlocksPerMultiprocessor(&per_cu, (const void*)hybrid_fwd, NTHREADS, LDS_BYTES) != hipSuccess || per_cu < 1)
            fprintf(stderr, "kernel_launch: note: occupancy query reports %d workgroups per CU\n", per_cu);
        (void)hipGetLastError();
        grid = cus;
    }
    if (grid < 0) return;
    if (hipMemsetAsync((char*)d_ws + WS_CTL, 0, CTL_ZERO_BYTES, stream) != hipSuccess) return;
    Args a{};
    for (int i = 0; i < 23; ++i) a.in[i] = (const float*)d_in[i];
    a.out = (float*)d_out; a.ws = (unsigned char*)d_ws;
#if MK_ONE_LAUNCH
    a.ph_lo = 0; a.ph_hi = NPHASES;
    hipLaunchKernelGGL(hybrid_fwd, dim3(grid), dim3(NTHREADS), LDS_BYTES, stream, a);
#else
    for (int ph = 0; ph < NPHASES; ++ph) { a.ph_lo = ph; a.ph_hi = ph + 1; hipLaunchKernelGGL(hybrid_fwd, dim3(grid), dim3(NTHREADS), LDS_BYTES, stream, a); }
#endif
}
```

```cpp
#include <hip/hip_runtime.h>
#include <cstdio>
#include <cstdint>
#include <cmath>
namespace pg8 {
#define PG8_LAS __attribute__((address_space(3)))
typedef unsigned short bf16_t;
typedef short bf16x8 __attribute__((ext_vector_type(8)));
typedef float f32x4 __attribute__((ext_vector_type(4)));
typedef unsigned u32x4 __attribute__((ext_vector_type(4)));
constexpr int BM = 256, BK = 64, HALF = 128, HTB = HALF * BK * 2  , STAGE_BYTES = 8 * HTB, NXCD = 8, WGM = 8;

__host__ __device__ __forceinline__ int lds_byte(int r, int c) { const int st = (r >> 4) * 2 + (c >> 5), rr = r & 15, cc = c & 31, ob = rr * 64 + cc * 2; return st * 1024 + (ob ^ (((ob >> 9) & 1) << 5)); }
__host__ __device__ __forceinline__ void stage_rc(int b, int& R, int& C) { const int st = b / 1024, sb = b % 1024, swz = sb ^ (((sb >> 9) & 1) << 5); R = (st >> 1) * 16 + swz / 64; C = (st & 1) * 32 + (swz % 64) / 2; }
__host__ __device__ __forceinline__ int perm32(int rho) { const int n = rho >> 4, i = rho & 15; return 8 * (i >> 2) + 4 * n + (i & 3); }

struct Unit { int pm, pn; };
struct Gemm { const bf16_t* A; const bf16_t* Bt; int M, N, K; };

struct StaticOrder {
    int nM, nN, nwg, G, c;
    __host__ __device__ void init(int M, int N, int G_, int c_) { nM = M / BM; nN = N / BM; nwg = nM * nN; G = G_; c = c_; }
    __host__ __device__ bool next(int i, Unit& u) const {
        const long L = (long)i * G + c; if (L >= nwg) return false;
        int wgid = (int)L; { const int q = nwg / NXCD, r = nwg % NXCD, xcd = wgid % NXCD, off = wgid / NXCD; wgid = (xcd < r ? xcd * (q + 1) : r * (q + 1) + (xcd - r) * q) + off; }
        const int nig = WGM * nN, gid = wgid / nig, fm = gid * WGM, gsz = (nM - fm) < WGM ? (nM - fm) : WGM;
        u.pm = fm + ((wgid % nig) % gsz); u.pn = (wgid % nig) / gsz; return true;
    }
    __device__ __forceinline__ void a_ready(const Unit&) const {}
    __device__ __forceinline__ void done(const Unit&) const {}
};

__device__ __forceinline__ unsigned cvt_pk_bf16(float lo, float hi) { unsigned r; asm volatile("v_cvt_pk_bf16_f32 %0, %1, %2" : "=v"(r) : "v"(lo), "v"(hi)); return r; }

struct EpiU {
    static constexpr bool PERM = true, AFTER_DRAIN = false;
    bf16_t* U; int ldu; float* DT; int n_full;
    __device__ __forceinline__ void operator()(const f32x4 (&acc)[2][2][4][2], const Unit& u, int wr, int wc, int fr, int fq) const {
        const int row0 = u.pm * BM + wr * 64 + fr;
        if (u.pn < n_full) {
            const int col0 = u.pn * BM + wc * 32 + 8 * fq;
#pragma unroll
            for (int ai = 0; ai < 2; ++ai)
#pragma unroll
                for (int m = 0; m < 4; ++m) { bf16_t* rowp = U + (size_t)(row0 + ai * HALF + m * 16) * ldu + col0;
#pragma unroll
                    for (int bj = 0; bj < 2; ++bj) { const f32x4 v0 = acc[ai][bj][m][0], v1 = acc[ai][bj][m][1];
                        u32x4 w; w.x = cvt_pk_bf16(v0[0], v0[1]); w.y = cvt_pk_bf16(v0[2], v0[3]); w.z = cvt_pk_bf16(v1[0], v1[1]); w.w = cvt_pk_bf16(v1[2], v1[3]);
                        *(u32x4*)(rowp + bj * HALF) = w; } }
        } else if (wc == 0 && fq < 2) {
#pragma unroll
            for (int ai = 0; ai < 2; ++ai)
#pragma unroll
                for (int m = 0; m < 4; ++m) { float* rowp = DT + (size_t)(row0 + ai * HALF + m * 16) * 16 + 8 * fq;
                    *(f32x4*)(rowp) = acc[ai][0][m][0]; *(f32x4*)(rowp + 4) = acc[ai][0][m][1]; }
        }
    }
};
struct EpiResid {
    static constexpr bool PERM = false, AFTER_DRAIN = false;
    const float* base; float* out; int ldc; const float* gate; int gate_stride; int rows_per_batch;
    __device__ __forceinline__ void operator()(const f32x4 (&acc)[2][2][4][2], const Unit& u, int wr, int wc, int fr, int fq) const {
        const int row0 = u.pm * BM + wr * 64 + fr, col0 = u.pn * BM + wc * 32 + 4 * fq;
        const float* gp = gate + (size_t)((u.pm * BM) / rows_per_batch) * gate_stride + col0;
        f32x4 gv[2][2];
#pragma unroll
        for (int bj = 0; bj < 2; ++bj)
#pragma unroll
            for (int n = 0; n < 2; ++n) gv[bj][n] = *(const f32x4*)(gp + bj * HALF + n * 16);
#pragma unroll
        for (int ai = 0; ai < 2; ++ai)
#pragma unroll
            for (int m = 0; m < 4; ++m) { const size_t off = (size_t)(row0 + ai * HALF + m * 16) * ldc + col0;
#pragma unroll
                for (int bj = 0; bj < 2; ++bj)
#pragma unroll
                    for (int n = 0; n < 2; ++n) { const f32x4 bs = *(const f32x4*)(base + off + bj * HALF + n * 16);
                        *(f32x4*)(out + off + bj * HALF + n * 16) = bs + gv[bj][n] * acc[ai][bj][m][n]; } }
    }
};

template <class Epi, class Sched, bool ALIGN_EPI = false, bool SP2 = false>
__device__ __forceinline__ void gemm_phase(PG8_LAS unsigned char* lds, const Gemm g, const Sched& S, const Epi& E, const int tid) {
    const int wid = __builtin_amdgcn_readfirstlane(tid >> 6), lane = tid & 63, wr = wid >> 2, wc = wid & 3, fr = lane & 15, fq = lane >> 4;
    const int K = g.K, nt = K / BK;
    unsigned voffA[2], voffB[2];
#pragma unroll
    for (int i = 0; i < 2; ++i) { int R, C; stage_rc(tid * 16 + i * 8192, R, C); const int Rb = Epi::PERM ? ((R & ~31) + perm32(R & 31)) : R;
        voffA[i] = (unsigned)(R * K + C) * 2u; voffB[i] = (unsigned)(Rb * K + C) * 2u; }
    const size_t kstep = (size_t)(BK * 2);
    const size_t hstep = (size_t)HALF * K * 2;
    const size_t tstep = 2 * hstep;
    const unsigned ldsw = (unsigned)wid * 1024u;
    const int aoff = lds_byte(wr * 64 + fr, fq * 8), boff = lds_byte(wc * 32 + fr, fq * 8);
#define PG8_SA(b, h) (((b) * 2 + (h)) * HTB)
#define PG8_SB(b, h) ((4 + (b) * 2 + (h)) * HTB)
#define PG8_STAGE(bufoff, gbase, voff) do { _Pragma("unroll") for (int _i = 0; _i < 2; ++_i) \
        __builtin_amdgcn_global_load_lds((const unsigned*)((const char*)(gbase) + (voff)[_i]), (PG8_LAS unsigned*)(lds + (bufoff) + ldsw + _i * 8192), 16, 0, 0); } while (0)
#define PG8_LDA(dst, b, h) do { _Pragma("unroll") for (int m = 0; m < 4; ++m) _Pragma("unroll") for (int k = 0; k < 2; ++k) dst[m][k] = *(const PG8_LAS bf16x8*)(lds + PG8_SA(b, h) + aoff + m * 2048 + k * 1024); } while (0)
#define PG8_LDB(dst, b, h) do { _Pragma("unroll") for (int n = 0; n < 2; ++n) _Pragma("unroll") for (int k = 0; k < 2; ++k) dst[n][k] = *(const PG8_LAS bf16x8*)(lds + PG8_SB(b, h) + boff + n * 2048 + k * 1024); } while (0)
#define PG8_MMA(ai, bj, At, Bt) do { __builtin_amdgcn_s_setprio(1); _Pragma("unroll") for (int m = 0; m < 4; ++m) _Pragma("unroll") for (int n = 0; n < 2; ++n) _Pragma("unroll") for (int k = 0; k < 2; ++k) \
        acc[ai][bj][m][n] = __builtin_amdgcn_mfma_f32_16x16x32_bf16(Bt[n][k], At[m][k], acc[ai][bj][m][n], 0, 0, 0); __builtin_amdgcn_s_setprio(0); } while (0)
#define PG8_WAIT_V(n) asm volatile("s_waitcnt vmcnt(" #n ")" ::: "memory")
#define PG8_WAIT_L(n) asm volatile("s_waitcnt lgkmcnt(" #n ")" ::: "memory")
#define PG8_BAR __builtin_amdgcn_s_barrier()
#define PG8_SCHED __builtin_amdgcn_sched_barrier(0)
    Unit cur, nxt; int ui = 0;
    if (!S.next(0, cur)) return;
    f32x4 acc[2][2][4][2];
#pragma unroll
    for (int a = 0; a < 2; ++a)
#pragma unroll
        for (int b = 0; b < 2; ++b)
#pragma unroll
            for (int m = 0; m < 4; ++m)
#pragma unroll
                for (int n = 0; n < 2; ++n) acc[a][b][m][n] = (f32x4){0.f, 0.f, 0.f, 0.f};
    bf16x8 At[4][2], B0[2][2], B1[2][2];
    const char* cA = (const char*)g.A + (size_t)cur.pm * tstep; const char* cB = (const char*)g.Bt + (size_t)cur.pn * tstep;
    S.a_ready(cur);
    if constexpr (SP2) {
        PG8_STAGE(PG8_SB(0, 0), cB, voffB); PG8_STAGE(PG8_SB(0, 1), cB + hstep, voffB); PG8_STAGE(PG8_SA(0, 0), cA, voffA); PG8_STAGE(PG8_SA(0, 1), cA + hstep, voffA);
        if (wr == 1) PG8_BAR;
        PG8_WAIT_V(2); PG8_BAR;
        PG8_STAGE(PG8_SB(1, 0), cB + kstep, voffB); PG8_STAGE(PG8_SA(1, 0), cA + kstep, voffA); PG8_STAGE(PG8_SB(1, 1), cB + hstep + kstep, voffB);
        PG8_WAIT_V(6); PG8_BAR;
    } else {
        PG8_STAGE(PG8_SB(0, 0), cB, voffB); PG8_STAGE(PG8_SA(0, 0), cA, voffA); PG8_STAGE(PG8_SB(0, 1), cB + hstep, voffB); PG8_STAGE(PG8_SA(0, 1), cA + hstep, voffA);
        if (wr == 1) PG8_BAR;
        PG8_WAIT_V(4); PG8_BAR;
        PG8_STAGE(PG8_SB(1, 0), cB + kstep, voffB); PG8_STAGE(PG8_SA(1, 0), cA + kstep, voffA); PG8_STAGE(PG8_SB(1, 1), cB + hstep + kstep, voffB);
        PG8_WAIT_V(6); PG8_BAR;
    }
    for (;;) {
        const bool has_next = S.next(ui + 1, nxt);
        const char* nA = has_next ? (const char*)g.A + (size_t)nxt.pm * tstep : cA; const char* nB = has_next ? (const char*)g.Bt + (size_t)nxt.pn * tstep : cB;
        for (int t = 0; t < nt; t += 2) {
            const bool last = (t == nt - 2);
            const char* a1 = cA + (size_t)(t + 1) * kstep;
            const char* a2 = last ? nA : cA + (size_t)(t + 2) * kstep; const char* b2 = last ? nB : cB + (size_t)(t + 2) * kstep;
            const char* a3 = a2 + kstep; const char* b3 = b2 + kstep;
            if (last && has_next) S.a_ready(nxt);
            if constexpr (SP2) {
            PG8_LDB(B0, 0, 0); PG8_LDB(B1, 0, 1); PG8_SCHED; PG8_LDA(At, 0, 0); PG8_STAGE(PG8_SA(1, 1), a1 + hstep, voffA);
            PG8_WAIT_V(8); PG8_WAIT_L(0); PG8_BAR; PG8_MMA(0, 0, At, B0); PG8_MMA(0, 1, At, B1); PG8_BAR; PG8_SCHED;
            PG8_LDA(At, 0, 1); PG8_STAGE(PG8_SB(0, 0), b2, voffB); PG8_STAGE(PG8_SB(0, 1), b2 + hstep, voffB); PG8_STAGE(PG8_SA(0, 0), a2, voffA);
            PG8_WAIT_V(8); PG8_WAIT_L(0); PG8_BAR; PG8_MMA(1, 0, At, B0); PG8_MMA(1, 1, At, B1); PG8_BAR; PG8_SCHED;
            PG8_LDB(B0, 1, 0); PG8_LDB(B1, 1, 1); PG8_SCHED; PG8_LDA(At, 1, 0); PG8_STAGE(PG8_SA(0, 1), a2 + hstep, voffA);
            PG8_WAIT_V(8); PG8_WAIT_L(0); PG8_BAR; PG8_MMA(0, 0, At, B0); PG8_MMA(0, 1, At, B1); PG8_BAR; PG8_SCHED;
            PG8_LDA(At, 1, 1); PG8_STAGE(PG8_SB(1, 0), b3, voffB); PG8_STAGE(PG8_SB(1, 1), b3 + hstep, voffB); PG8_STAGE(PG8_SA(1, 0), a3, voffA);
            PG8_WAIT_V(8); PG8_WAIT_L(0); PG8_BAR; PG8_MMA(1, 0, At, B0); PG8_MMA(1, 1, At, B1); PG8_BAR; PG8_SCHED;
            } else {
            PG8_LDB(B0, 0, 0); PG8_SCHED; PG8_LDA(At, 0, 0); PG8_STAGE(PG8_SA(1, 1), a1 + hstep, voffA);
            PG8_WAIT_L(8); PG8_BAR; PG8_WAIT_L(0); PG8_MMA(0, 0, At, B0); PG8_BAR; PG8_SCHED;
            PG8_LDB(B1, 0, 1); PG8_STAGE(PG8_SB(0, 0), b2, voffB);
            PG8_BAR; PG8_WAIT_L(0); PG8_MMA(0, 1, At, B1); PG8_BAR;
            PG8_LDA(At, 0, 1); PG8_STAGE(PG8_SA(0, 0), a2, voffA);
            PG8_BAR; PG8_WAIT_L(0); PG8_MMA(1, 0, At, B0); PG8_BAR; PG8_SCHED;
            PG8_STAGE(PG8_SB(0, 1), b2 + hstep, voffB);
            PG8_WAIT_V(6); PG8_BAR; PG8_MMA(1, 1, At, B1); PG8_BAR;
            PG8_LDB(B0, 1, 0); PG8_SCHED; PG8_LDA(At, 1, 0); PG8_STAGE(PG8_SA(0, 1), a2 + hstep, voffA);
            PG8_WAIT_L(8); PG8_BAR; PG8_WAIT_L(0); PG8_MMA(0, 0, At, B0); PG8_BAR; PG8_SCHED;
            PG8_LDB(B1, 1, 1); PG8_STAGE(PG8_SB(1, 0), b3, voffB);
            PG8_BAR; PG8_WAIT_L(0); PG8_MMA(0, 1, At, B1); PG8_BAR;
            PG8_LDA(At, 1, 1); PG8_STAGE(PG8_SA(1, 0), a3, voffA);
            PG8_BAR; PG8_WAIT_L(0); PG8_MMA(1, 0, At, B0); PG8_BAR; PG8_SCHED;
            PG8_STAGE(PG8_SB(1, 1), b3 + hstep, voffB);
            PG8_WAIT_V(6); PG8_BAR; PG8_MMA(1, 1, At, B1); PG8_BAR;
            }
        }
        if constexpr (ALIGN_EPI) { if (wr == 0) PG8_BAR; }
        if constexpr (!Epi::AFTER_DRAIN) { E(acc, cur, wr, wc, fr, fq); S.done(cur); }
        if (!has_next) break;
#pragma unroll
        for (int a = 0; a < 2; ++a)
#pragma unroll
            for (int b = 0; b < 2; ++b)
#pragma unroll
                for (int m = 0; m < 4; ++m)
#pragma unroll
                    for (int n = 0; n < 2; ++n) acc[a][b][m][n] = (f32x4){0.f, 0.f, 0.f, 0.f};
        cur = nxt; cA = nA; cB = nB; ++ui;
        if constexpr (ALIGN_EPI) { if (wr == 1) PG8_BAR; }
    }
    PG8_WAIT_V(0);
    if constexpr (!ALIGN_EPI) { if (wr == 0) PG8_BAR; }
    PG8_BAR;
    if constexpr (Epi::AFTER_DRAIN) { E.fused(acc, cur, wr, wc, fr, fq, lds, wid, lane); S.done(cur); }
#undef PG8_SA
#undef PG8_SB
#undef PG8_STAGE
#undef PG8_LDA
#undef PG8_LDB
#undef PG8_MMA
#undef PG8_WAIT_V
#undef PG8_WAIT_L
#undef PG8_BAR
#undef PG8_SCHED
}
}
constexpr int NWAVES = 8, NTHREADS = 512;
constexpr int BATCH = 8, SEQ = 2048, DM = 1024, DEPTH = 4, M = BATCH * SEQ;
constexpr int NIN = 5648, NU = 5632, NIN_PAD = 5888, DIN = 2048;
constexpr int C_AX = 0, C_AG = 512, C_HQ = 1024, C_HF = 1536, C_HI = 2048, C_HG = 2560, C_Z = 3072, C_XBC = 4096, C_B = 5120, C_C = 5376;
constexpr int Y_A = 0, Y_B = 512, Y_C = 1024;
constexpr float EPS = 1e-6f;
constexpr int NSSQ = 96;

constexpr size_t MiB = 1u << 20;
constexpr size_t WS_CTL = 0, CTL_ZERO_BYTES = 1 * MiB;
constexpr size_t WS_WIN = 2 * MiB;
constexpr size_t WS_WOUT = 48 * MiB;
constexpr size_t WS_MOD = 64 * MiB;
constexpr size_t WS_DT = 65 * MiB;
constexpr size_t WS_SSQ = 340 * MiB;
constexpr size_t WS_H = 68 * MiB;
constexpr size_t WS_Y = 100 * MiB;
constexpr size_t WS_U = 164 * MiB;
constexpr size_t WS_END = 346 * MiB;
static_assert(WS_WIN + (size_t)DEPTH * NIN_PAD * DM * 2 <= WS_WOUT && WS_WOUT + (size_t)DEPTH * DM * DIN * 2 <= WS_MOD && WS_U + (size_t)M * NU * 2 <= WS_SSQ && WS_SSQ + (size_t)M * NSSQ * 4 <= WS_END, "d_ws map");
constexpr int CW_BAR = 4096;

constexpr int RING_OFF = 0, RING_BYTES = 131072;
constexpr int LDSCTL_OFF = RING_BYTES, MISC_OFF = LDSCTL_OFF + 320;
constexpr int LDS_BYTES = 147456;

#define GAS __attribute__((address_space(1)))
#define LAS __attribute__((address_space(3)))
typedef unsigned short bf16;
typedef unsigned v4u __attribute__((ext_vector_type(4)));
typedef float f32x4 __attribute__((ext_vector_type(4)));
typedef short bf16x8 __attribute__((ext_vector_type(8)));
typedef GAS unsigned gu32;
typedef GAS unsigned long long gu64;
#define RLX_AGENT __ATOMIC_RELAXED, __HIP_MEMORY_SCOPE_AGENT
#define LDS_WAIT() asm volatile("s_waitcnt lgkmcnt(0)" ::: "memory")
#define VM_WAIT() asm volatile("s_waitcnt vmcnt(0)" ::: "memory")
__device__ __forceinline__ unsigned long long rt() { return __builtin_amdgcn_s_memrealtime(); }
__device__ __forceinline__ unsigned f2bf(float f) { unsigned u = __builtin_bit_cast(unsigned, f); return (u + 0x7fffu + ((u >> 16) & 1u)) >> 16; }
__device__ __forceinline__ unsigned pk2(float lo, float hi) { return f2bf(lo) | (f2bf(hi) << 16); }

#define XB_TMO      128
#define XB_XCNT(j)  (256  + 64 * (j))
#define XB_XSUB(j)  (1280 + 64 * (j))
#define XB_XGEN(j)  (2304 + 64 * (j))
#define XB_TOP      3328
#define XB_TOPGEN   3392
#define XCD_BAR_WORDS 3456
#define XB_SPIN_CAP (1u << 18)

__device__ __forceinline__ unsigned xb_ld(unsigned* p)              { return __hip_atomic_load(p, __ATOMIC_RELAXED, __HIP_MEMORY_SCOPE_AGENT); }
__device__ __forceinline__ unsigned xb_add(unsigned* p, unsigned v) { return __hip_atomic_fetch_add(p, v, __ATOMIC_RELAXED, __HIP_MEMORY_SCOPE_AGENT); }
__device__ __forceinline__ unsigned xb_xcc_id() { return (unsigned)__builtin_amdgcn_s_getreg((3 << 11) | 20) & 0xFu; }
#define XB_SPIN(cond, bar) do { unsigned _sp = 0; while (cond) { __builtin_amdgcn_s_sleep(1); \
    if ((++_sp & 255u) == 0u) { if (xb_ld(&(bar)[XB_TMO])) break; if (_sp > XB_SPIN_CAP) { atomicAdd(&(bar)[XB_TMO], 1u); break; } } } } while (0)

struct XcdBarrier {
    unsigned* bar; unsigned x;
    volatile LAS unsigned* st;
};

__device__ __forceinline__ XcdBarrier xcd_barrier_post(unsigned* bar, volatile LAS unsigned* st) {
    XcdBarrier b; b.bar = bar; b.x = xb_xcc_id(); b.st = st;
    if (threadIdx.x == 0) (void)xb_add(&bar[XB_XCNT(b.x)], 1u);
    return b;
}
__device__ __forceinline__ void xcd_barrier_complete(unsigned* bar, unsigned x, unsigned& nloc, unsigned& nx) {
    const unsigned G = gridDim.x * gridDim.y * gridDim.z;
    unsigned sum, cnt, mine, sp = 0u;
    for (;;) {
        sum = 0u; cnt = 0u; mine = 0u;
#pragma unroll
        for (unsigned j = 0; j < 16; ++j) { const unsigned c = xb_ld(&bar[XB_XCNT(j)]); sum += c; cnt += (c > 0u) ? 1u : 0u; mine = (j == x) ? c : mine; }
        if (sum == G) break;
        __builtin_amdgcn_s_sleep(1);
        if ((++sp & 255u) == 0u) { if (xb_ld(&bar[XB_TMO])) break; if (sp > XB_SPIN_CAP) { atomicAdd(&bar[XB_TMO], 1u); break; } }
    }
    nloc = mine > 0u ? mine : 1u; nx = cnt > 0u ? cnt : 1u;
}

__device__ __forceinline__ void xcd_barrier(const XcdBarrier& b) {
    asm volatile("s_waitcnt vmcnt(0)" ::: "memory");
    __syncthreads();
    if (threadIdx.x == 0) {
        unsigned* bar = b.bar;
        __builtin_amdgcn_s_waitcnt(0);
        unsigned nloc = b.st[0], nx = b.st[1];
        if (nloc == 0u) { xcd_barrier_complete(bar, b.x, nloc, nx); b.st[0] = nloc; b.st[1] = nx; }
        const unsigned old = xb_add(&bar[XB_XSUB(b.x)], 1u);
        const unsigned gen = old / nloc;
        if (old + 1u == (gen + 1u) * nloc) {
            __builtin_amdgcn_fence(__ATOMIC_RELEASE, "agent");
            asm volatile("s_waitcnt vmcnt(0)" ::: "memory");
            const unsigned og = xb_add(&bar[XB_TOP], 1u);
            const unsigned tg = og / nx;
            if (og + 1u == (tg + 1u) * nx) xb_add(&bar[XB_TOPGEN], 1u);
            else XB_SPIN(xb_ld(&bar[XB_TOPGEN]) == tg, bar);
            __builtin_amdgcn_fence(__ATOMIC_ACQUIRE, "agent");
            xb_add(&bar[XB_XGEN(b.x)], 1u);
            asm volatile("s_waitcnt vmcnt(0)" ::: "memory");
        } else {
            XB_SPIN(xb_ld(&bar[XB_XGEN(b.x)]) == gen, bar);
            __builtin_amdgcn_fence(__ATOMIC_ACQUIRE, "agent");
            asm volatile("s_waitcnt vmcnt(0)" ::: "memory");
        }
    }
    __syncthreads();
}
struct Frame {
    LAS unsigned char* lds;
    int tid, lane, wave;
    int vcu, G, bx;
};
struct Args { const float* in[23]; float* out; unsigned char* ws; int ph_lo, ph_hi; };
typedef const __attribute__((address_space(4))) Args* KA;
#define P_WIN  ((bf16*)(A->ws + WS_WIN))
#define P_WOUT ((bf16*)(A->ws + WS_WOUT))
#define P_H    ((bf16*)(A->ws + WS_H))
#define P_Y    ((bf16*)(A->ws + WS_Y))
#define P_U    ((bf16*)(A->ws + WS_U))
#define P_MOD  ((float*)(A->ws + WS_MOD))
#define P_DT   ((float*)(A->ws + WS_DT))
#define P_SSQ  ((float*)(A->ws + WS_SSQ))
enum { I_X = 0, I_C, I_NORMW, I_WADA, I_BADA, I_WIN, I_LCW, I_LCB, I_LWA, I_LBA, I_LWX, I_LBX, I_LLAM, I_HGLB, I_HGNW, I_SCW, I_SCB, I_SDTB, I_SALOG, I_SD, I_SNW, I_WOUT, I_FNW };

__device__ __forceinline__ float bf2f(bf16 h) { return __uint_as_float((unsigned)h << 16); }
__device__ __forceinline__ float sigmoidf_(float x) { return 1.0f / (1.0f + __expf(-x)); }
__device__ __forceinline__ float siluf_(float x) { return x * sigmoidf_(x); }
__device__ __forceinline__ float softplusf_(float x) { return x > 20.f ? x : log1pf(__expf(x)); }
__device__ __forceinline__ float wave_sum(float v) {
#pragma unroll
    for (int o = 1; o < 64; o <<= 1) v += __shfl_xor(v, o);
    return v;
}

__device__ __forceinline__ void p0_transpose_item(const float* W, int K, int N, bf16* WT, LAS float* scr, int item, int lane) {
    const int nblk = (N + 31) / 32, kb = item / nblk, nb = item % nblk, k0 = 64 * kb, n0 = 32 * nb;
    const int nn = n0 + (lane & 31); const bool okc = nn < N;
#pragma unroll 8
    for (int i = 0; i < 32; ++i) { const int kk = 2 * i + (lane >> 5); scr[kk * 33 + (lane & 31)] = okc ? W[(size_t)(k0 + kk) * N + nn] : 0.f; }
    LDS_WAIT(); asm volatile("" ::: "memory");
    const int c = lane & 7;
#pragma unroll
    for (int j = 0; j < 4; ++j) { const int n = (lane >> 3) + 8 * j; const LAS float* s = scr + (8 * c) * 33 + n;
        v4u o; o.x = pk2(s[0 * 33], s[1 * 33]); o.y = pk2(s[2 * 33], s[3 * 33]); o.z = pk2(s[4 * 33], s[5 * 33]); o.w = pk2(s[6 * 33], s[7 * 33]);
        *(GAS v4u*)(WT + (size_t)(n0 + n) * K + k0 + 8 * c) = o; }
    LDS_WAIT(); asm volatile("" ::: "memory");
}

__device__ __forceinline__ void p0_prologue(Frame& F, KA A) {
    {
        LAS float* scr = (LAS float*)(F.lds + RING_OFF + F.wave * 16384);
        const int gw = F.vcu * NWAVES + F.wave, NGW = F.G * NWAVES;
        constexpr int I_IN = (DM / 64) * ((NIN + 31) / 32), I_OUT = (DIN / 64) * (DM / 32), I_ZERO = (NIN_PAD - 5664) * DM * 2 / 1024;
        constexpr int PER_L = I_IN + I_OUT + I_ZERO, NITEMS = DEPTH * PER_L;
        for (int it = gw; it < NITEMS; it += NGW) {
            const int l = it / PER_L; int r = it % PER_L;
            bf16* win = P_WIN + (size_t)l * NIN_PAD * DM; bf16* wout = P_WOUT + (size_t)l * DM * DIN;
            if (r < I_IN) { p0_transpose_item(A->in[I_WIN] + (size_t)l * DM * NIN, DM, NIN, win, scr, r, F.lane); continue; } r -= I_IN;
            if (r < I_OUT) { p0_transpose_item(A->in[I_WOUT] + (size_t)l * DIN * DM, DIN, DM, wout, scr, r, F.lane); continue; } r -= I_OUT;
            *(GAS v4u*)((unsigned char*)(win + (size_t)5664 * DM) + (size_t)r * 1024 + F.lane * 16) = (v4u){0u, 0u, 0u, 0u};
        }
    }
    __syncthreads();
    {
        LAS float* part = (LAS float*)(F.lds + RING_OFF);
        const float* cc = A->in[I_C];
        for (int un = F.vcu; un < DEPTH * 48; un += F.G) {
            const int l = un / 48, n0 = (un % 48) * 64;
            const float* w = A->in[I_WADA] + (size_t)l * DM * 3 * DM + n0 + F.lane;
            float acc[8];
#pragma unroll
            for (int b = 0; b < 8; ++b) acc[b] = 0.f;
            for (int k = F.wave * 128; k < F.wave * 128 + 128; ++k) {
                const float wv = w[(size_t)k * 3 * DM];
#pragma unroll
                for (int b = 0; b < 8; ++b) { const float cv = cc[b * DM + k]; acc[b] += siluf_(cv) * wv; }
            }
#pragma unroll
            for (int b = 0; b < 8; ++b) part[(F.wave * 8 + b) * 64 + F.lane] = acc[b];
            __syncthreads();
            { const int b = F.wave; float s = 0.f;
#pragma unroll
              for (int w8 = 0; w8 < 8; ++w8) s += part[(w8 * 8 + b) * 64 + F.lane];
              P_MOD[((size_t)l * BATCH + b) * 3 * DM + n0 + F.lane] = s + A->in[I_BADA][(size_t)l * 3 * DM + n0 + F.lane]; }
            __syncthreads();
        }
    }
}

__device__ __forceinline__ void norm_phase(Frame& F, KA A, const float* xsrc, int l) {
    const int gw = F.vcu * NWAVES + F.wave, NGW = F.G * NWAVES;
    const float* nw = A->in[I_NORMW] + (size_t)l * DM;
    for (int m = gw; m < M; m += NGW) {
        const int b = m / SEQ;
        const float* shift = P_MOD + ((size_t)l * BATCH + b) * 3 * DM; const float* scale = shift + DM;
        const GAS f32x4* xr = (const GAS f32x4*)(xsrc + (size_t)m * DM) + F.lane;
        f32x4 v[4]; float s = 0.f;
#pragma unroll
        for (int j = 0; j < 4; ++j) { v[j] = xr[64 * j]; s += (v[j].x * v[j].x + v[j].y * v[j].y) + (v[j].z * v[j].z + v[j].w * v[j].w); }
        const float inv = 1.0f / sqrtf(wave_sum(s) * (1.f / DM) + EPS);
        GAS unsigned long long* o8 = (GAS unsigned long long*)(P_H + (size_t)m * DM) + F.lane;
#pragma unroll
        for (int j = 0; j < 4; ++j) { const int k = 4 * F.lane + 256 * j;
            const f32x4 w4 = *(const f32x4*)(nw + k), sc = *(const f32x4*)(scale + k), sh = *(const f32x4*)(shift + k);
            const f32x4 hv = (v[j] * inv) * w4 * (sc + 1.0f) + sh;
            o8[64 * j] = (unsigned long long)pk2(hv.x, hv.y) | ((unsigned long long)pk2(hv.z, hv.w) << 32); }
    }
}
__device__ __forceinline__ void final_norm_phase(Frame& F, KA A) {
    const int gw = F.vcu * NWAVES + F.wave, NGW = F.G * NWAVES;
    const float* nw = A->in[I_FNW];
    for (int m = gw; m < M; m += NGW) {
        GAS f32x4* xr = (GAS f32x4*)(A->out + (size_t)m * DM) + F.lane;
        f32x4 v[4]; float s = 0.f;
#pragma unroll
        for (int j = 0; j < 4; ++j) { v[j] = xr[64 * j]; s += (v[j].x * v[j].x + v[j].y * v[j].y) + (v[j].z * v[j].z + v[j].w * v[j].w); }
        const float inv = 1.0f / sqrtf(wave_sum(s) * (1.f / DM) + EPS);
#pragma unroll
        for (int j = 0; j < 4; ++j) { const f32x4 w4 = *(const f32x4*)(nw + 4 * F.lane + 256 * j); xr[64 * j] = (v[j] * inv) * w4; }
    }
}
__device__ __forceinline__ void ynorm_phase(Frame& F, KA A) {
    const int gw = F.vcu * NWAVES + F.wave, NGW = F.G * NWAVES;
    for (int m = gw; m < M; m += NGW) {
        const float* sq = P_SSQ + (size_t)m * NSSQ;
        const float q0 = sq[F.lane], q1 = (F.lane < 32) ? sq[64 + F.lane] : 0.f;
        float sc[3];
        sc[0] = 1.0f / sqrtf(wave_sum(q1) * (1.f / 512.f) + EPS);
        sc[1] = 1.0f / sqrtf(wave_sum(F.lane < 32 ? q0 : 0.f) * (1.f / 512.f) + EPS);
        sc[2] = 1.0f / sqrtf(wave_sum(F.lane < 32 ? 0.f : q0) * (1.f / 512.f) + EPS);
        GAS v4u* yr = (GAS v4u*)(P_Y + (size_t)m * DIN + Y_B) + F.lane;
#pragma unroll
        for (int s3 = 0; s3 < 3; ++s3) { v4u w = yr[64 * s3]; const float f = sc[s3];
            w.x = pk2(__uint_as_float(w.x << 16) * f, __uint_as_float(w.x & 0xffff0000u) * f);
            w.y = pk2(__uint_as_float(w.y << 16) * f, __uint_as_float(w.y & 0xffff0000u) * f);
            w.z = pk2(__uint_as_float(w.z << 16) * f, __uint_as_float(w.z & 0xffff0000u) * f);
            w.w = pk2(__uint_as_float(w.w << 16) * f, __uint_as_float(w.w & 0xffff0000u) * f);
            yr[64 * s3] = w; }
    }
}
typedef short bf16x4_t __attribute__((ext_vector_type(4)));
typedef unsigned v2u __attribute__((ext_vector_type(2)));
#define MFMA16(a, b, c) __builtin_amdgcn_mfma_f32_16x16x32_bf16((a), (b), (c), 0, 0, 0)
__device__ __forceinline__ float clamp80(float x) { return fminf(fmaxf(x, -80.f), 80.f); }
__device__ __forceinline__ bf16x8 pack8(f32x4 lo, f32x4 hi) { v4u w; w.x = pk2(lo.x, lo.y); w.y = pk2(lo.z, lo.w); w.z = pk2(hi.x, hi.y); w.w = pk2(hi.z, hi.w); return __builtin_bit_cast(bf16x8, w); }
__device__ __forceinline__ v2u pack4(f32x4 v) { v2u w; w.x = pk2(v.x, v.y); w.y = pk2(v.z, v.w); return w; }
__device__ __forceinline__ bf16x8 ld8x2(const LAS unsigned char* p0, const LAS unsigned char* p1) {
    const v2u a = *(const LAS v2u*)p0, b = *(const LAS v2u*)p1; v4u w; w.x = a.x; w.y = a.y; w.z = b.x; w.w = b.y; return __builtin_bit_cast(bf16x8, w); }

__device__ __forceinline__ void hgrn_unit(Frame& F, KA A, int l, int b, int h) {
    constexpr int QT_OFF = 0, KT_OFF = 17408, KTT_OFF = 34816, VT_OFF = 53248, PT_OFF = 71680, PART_OFF = 80896, ER_OFF = 82944, EC_OFF = 83456;
    LAS unsigned char* L = F.lds + RING_OFF;
    const int tid = F.tid, lane = F.lane, wave = F.wave, fr = lane & 15, fq = lane >> 4;
    const int d = tid & 127, c = h * 128 + d, tq = tid >> 7;
    float lb;
    { float lg[4], mx = -1e30f;
#pragma unroll
      for (int q = 0; q < 4; ++q) { lg[q] = A->in[I_HGLB][(size_t)q * 512 + c]; mx = fmaxf(mx, lg[q]); }
      float sum = 0.f;
#pragma unroll
      for (int q = 0; q < 4; ++q) { lg[q] = __expf(lg[q] - mx); sum += lg[q]; }
      lb = 0.f;
#pragma unroll
      for (int q = 1; q < 4; ++q) if (q <= l) lb += lg[q] / sum; }
    const float omlb = 1.f - lb;
    f32x4 S[8];
#pragma unroll
    for (int i = 0; i < 8; ++i) S[i] = (f32x4){0.f, 0.f, 0.f, 0.f};
    const int vb = h * 128 + 16 * wave + 4 * fq;
    const f32x4 nw4 = *(const f32x4*)(A->in[I_HGNW] + (size_t)l * 512 + vb);
    const bf16* Ub = P_U + (size_t)b * SEQ * NU;
    bf16* Yb = P_Y + (size_t)b * SEQ * DIN;
    float* SQb = P_SSQ + (size_t)b * SEQ * NSSQ;
    for (int chunk = 0; chunk < SEQ / 64; ++chunk) {
        const int t0 = chunk * 64;
        float qq[16], kk[16], cum[16];
        { unsigned vv[8];
          float run = 0.f;
#pragma unroll
          for (int i = 0; i < 16; ++i) { const bf16* ur = Ub + (size_t)(t0 + 16 * tq + i) * NU;
              const float q = bf2f(ur[C_HQ + c]), hf = bf2f(ur[C_HF + c]); const unsigned vi = ur[C_HI + c];
              const float sg = sigmoidf_(hf); const float f = lb + omlb * sg;
              run += __logf(f); cum[i] = run; kk[i] = omlb * (1.f - sg); qq[i] = siluf_(q);
              if (i & 1) vv[i >> 1] |= vi << 16; else vv[i >> 1] = vi; }
          ((LAS float*)(L + PART_OFF))[tq * 128 + d] = run;
          *(LAS v4u*)(L + VT_OFF + d * 144 + tq * 32) = (v4u){vv[0], vv[1], vv[2], vv[3]};
          *(LAS v4u*)(L + VT_OFF + d * 144 + tq * 32 + 16) = (v4u){vv[4], vv[5], vv[6], vv[7]}; }
        __syncthreads();
        { const LAS float* part = (const LAS float*)(L + PART_OFF);
          const float p0 = part[d], p1 = part[128 + d], p2 = part[256 + d], p3 = part[384 + d];
          const float r = p0 + p1, c63 = (p0 + p1) + (p2 + p3);
          const float pre = (tq == 0) ? 0.f : (tq == 1) ? p0 : (tq == 2) ? (p0 + p1) : (p0 + p1 + p2);
          unsigned kt[8];
#pragma unroll
          for (int i = 0; i < 16; ++i) { const float cm = cum[i] + pre;
              const float qv = qq[i] * __expf(clamp80(cm - r)), kv = kk[i] * __expf(clamp80(r - cm));
              const int t = 16 * tq + i;
              *(LAS bf16*)(L + QT_OFF + t * 272 + d * 2) = (bf16)f2bf(qv);
              const unsigned kb = f2bf(kv);
              *(LAS bf16*)(L + KT_OFF + t * 272 + d * 2) = (bf16)kb;
              if (i & 1) kt[i >> 1] |= kb << 16; else kt[i >> 1] = kb; }
          *(LAS v4u*)(L + KTT_OFF + d * 144 + tq * 32) = (v4u){kt[0], kt[1], kt[2], kt[3]};
          *(LAS v4u*)(L + KTT_OFF + d * 144 + tq * 32 + 16) = (v4u){kt[4], kt[5], kt[6], kt[7]};
          if (tq == 0) { ((LAS float*)(L + ER_OFF))[d] = __expf(clamp80(r)); ((LAS float*)(L + EC_OFF))[d] = __expf(clamp80(c63 - r)); } }
        __syncthreads();
#pragma unroll
        for (int k2 = 0; k2 < 2; ++k2) { const int id = 2 * wave + k2, st = id >> 2, tt = id & 3;
            f32x4 acc = (f32x4){0.f, 0.f, 0.f, 0.f};
            if (st <= tt) {
#pragma unroll
                for (int ks = 0; ks < 4; ++ks) { const bf16x8 a = *(const LAS bf16x8*)(L + KT_OFF + (16 * st + fr) * 272 + (4 * ks + fq) * 16);
                    const bf16x8 bq = *(const LAS bf16x8*)(L + QT_OFF + (16 * tt + fr) * 272 + (4 * ks + fq) * 16);
                    acc = MFMA16(a, bq, acc); }
                if (st == tt) {
#pragma unroll
                    for (int r4 = 0; r4 < 4; ++r4) if (4 * fq + r4 > fr) acc[r4] = 0.f; } }
            *(LAS v2u*)(L + PT_OFF + (16 * tt + fr) * 144 + (16 * st + 4 * fq) * 2) = pack4(acc); }
        __syncthreads();
        { const LAS float* er = (const LAS float*)(L + ER_OFF);
#pragma unroll
          for (int i = 0; i < 8; ++i) S[i] = S[i] * *(const LAS f32x4*)(er + 16 * i + 4 * fq); }
        f32x4 o[4];
#pragma unroll
        for (int tt = 0; tt < 4; ++tt) o[tt] = (f32x4){0.f, 0.f, 0.f, 0.f};
#pragma unroll
        for (int ks = 0; ks < 4; ++ks) { const bf16x8 sa = pack8(S[2 * ks], S[2 * ks + 1]);
#pragma unroll
            for (int tt = 0; tt < 4; ++tt) { const LAS unsigned char* qrow = L + QT_OFF + (16 * tt + fr) * 272 + (32 * ks + 4 * fq) * 2;
                o[tt] = MFMA16(sa, ld8x2(qrow, qrow + 32), o[tt]); } }
        bf16x8 va[2];
#pragma unroll
        for (int ks2 = 0; ks2 < 2; ++ks2) va[ks2] = *(const LAS bf16x8*)(L + VT_OFF + (16 * wave + fr) * 144 + (32 * ks2 + 8 * fq) * 2);
#pragma unroll
        for (int ks2 = 0; ks2 < 2; ++ks2)
#pragma unroll
            for (int tt = 0; tt < 4; ++tt) if (32 * ks2 <= 16 * tt + 15) {
                const bf16x8 pb = *(const LAS bf16x8*)(L + PT_OFF + (16 * tt + fr) * 144 + (32 * ks2 + 8 * fq) * 2);
                o[tt] = MFMA16(va[ks2], pb, o[tt]); }
#pragma unroll
        for (int i = 0; i < 8; ++i)
#pragma unroll
            for (int ks2 = 0; ks2 < 2; ++ks2) { const bf16x8 ka = *(const LAS bf16x8*)(L + KTT_OFF + (16 * i + fr) * 144 + (32 * ks2 + 8 * fq) * 2);
                S[i] = MFMA16(ka, va[ks2], S[i]); }
        { const LAS float* ec = (const LAS float*)(L + EC_OFF);
#pragma unroll
          for (int i = 0; i < 8; ++i) S[i] = S[i] * *(const LAS f32x4*)(ec + 16 * i + 4 * fq); }
#pragma unroll
        for (int tt = 0; tt < 4; ++tt) { const size_t t = t0 + 16 * tt + fr;
            const v2u gw = *(const v2u*)(Ub + t * NU + C_HG + vb);
            f32x4 g4; g4.x = __uint_as_float(gw.x << 16); g4.y = __uint_as_float(gw.x & 0xffff0000u); g4.z = __uint_as_float(gw.y << 16); g4.w = __uint_as_float(gw.y & 0xffff0000u);
            const f32x4 ov = o[tt];
            float ss = (ov.x * ov.x + ov.y * ov.y) + (ov.z * ov.z + ov.w * ov.w);
            ss += __shfl_xor(ss, 16); ss += __shfl_xor(ss, 32);
            f32x4 yv; yv.x = ov.x * nw4.x * siluf_(g4.x); yv.y = ov.y * nw4.y * siluf_(g4.y); yv.z = ov.z * nw4.z * siluf_(g4.z); yv.w = ov.w * nw4.w * siluf_(g4.w);
            *(v2u*)(Yb + t * DIN + Y_B + vb) = pack4(yv);
            if (fq == 0) SQb[t * NSSQ + 64 + h * 8 + wave] = ss; }
        __syncthreads();
    }
}
__device__ __forceinline__ void ssd_unit(Frame& F, KA A, int l, int b, int hh) {
    constexpr int BM_OFF = 0, CM_OFF = 17408, BT_OFF = 34816, XT_OFF = 53248, WT_OFF = 62464, SB_OFF = 71680, SC_OFF = 106496;
    LAS unsigned char* L = F.lds + RING_OFF;
    const int tid = F.tid, lane = F.lane, wave = F.wave, fr = lane & 15, fq = lane >> 4;
    const int g = hh >> 3, n = tid & 127, tq = tid >> 7, p = tid & 63, t8 = tid >> 6;
    const float* cwp = A->in[I_SCW] + (size_t)l * 4 * 1536; const float* cbp = A->in[I_SCB] + (size_t)l * 1536;
    const int chB = 1024 + g * 128 + n, chC = 1280 + g * 128 + n, chX = hh * 64 + p;
    float wB[4], wC[4], wX[4];
#pragma unroll
    for (int k = 0; k < 4; ++k) { wB[k] = cwp[k * 1536 + chB]; wC[k] = cwp[k * 1536 + chC]; wX[k] = cwp[k * 1536 + chX]; }
    const float bB = cbp[chB], bC = cbp[chC], bX = cbp[chX];
    const float Ah = -__expf(A->in[I_SALOG][l * 16 + hh]), dtb = A->in[I_SDTB][l * 16 + hh], Dh = A->in[I_SD][l * 16 + hh];
    const int pt = wave >> 1, tts = (wave & 1) * 2;
    const int pb = hh * 64 + 16 * pt + 4 * fq;
    const f32x4 nw4 = *(const f32x4*)(A->in[I_SNW] + (size_t)l * 1024 + pb);
    f32x4 ST[4];
#pragma unroll
    for (int i = 0; i < 4; ++i) ST[i] = (f32x4){0.f, 0.f, 0.f, 0.f};
    for (int i = tid; i < 17408 / 16; i += NTHREADS) *(LAS v4u*)(L + SB_OFF + i * 16) = (v4u){0u, 0u, 0u, 0u};
    const bf16* Ub = P_U + (size_t)b * SEQ * NU;
    bf16* Yb = P_Y + (size_t)b * SEQ * DIN;
    float* SQb = P_SSQ + (size_t)b * SEQ * NSSQ;
    const float* DTb = P_DT + (size_t)b * SEQ * 16;
    LAS float* SC = (LAS float*)(L + SC_OFF);
    for (int chunk = 0; chunk < SEQ / 64; ++chunk) {
        const int t0 = chunk * 64, cur = chunk & 1;
        { float rb[19], rc[19];
#pragma unroll
          for (int j = 0; j < 19; ++j) { const int ts = t0 + 16 * tq - 3 + j; if (ts >= 0) { rb[j] = bf2f(Ub[(size_t)ts * NU + C_XBC + chB]); rc[j] = bf2f(Ub[(size_t)ts * NU + C_XBC + chC]); } else { rb[j] = 0.f; rc[j] = 0.f; } }
          unsigned bt[8];
#pragma unroll
          for (int i = 0; i < 16; ++i) { float ab = bB, ac = bC;
#pragma unroll
              for (int k = 0; k < 4; ++k) { ab += wB[k] * rb[i + k]; ac += wC[k] * rc[i + k]; }
              const unsigned ub = f2bf(siluf_(ab)), uc = f2bf(siluf_(ac)); const int t = 16 * tq + i;
              *(LAS bf16*)(L + BM_OFF + t * 272 + n * 2) = (bf16)ub; *(LAS bf16*)(L + CM_OFF + t * 272 + n * 2) = (bf16)uc;
              if (i & 1) bt[i >> 1] |= ub << 16; else bt[i >> 1] = ub; }
          *(LAS v4u*)(L + BT_OFF + n * 144 + tq * 32) = (v4u){bt[0], bt[1], bt[2], bt[3]};
          *(LAS v4u*)(L + BT_OFF + n * 144 + tq * 32 + 16) = (v4u){bt[4], bt[5], bt[6], bt[7]}; }
        { float rx[11];
#pragma unroll
          for (int j = 0; j < 11; ++j) { const int ts = t0 + 8 * t8 - 3 + j; rx[j] = (ts >= 0) ? bf2f(Ub[(size_t)ts * NU + C_XBC + chX]) : 0.f; }
          unsigned xt[4];
#pragma unroll
          for (int i = 0; i < 8; ++i) { float ax = bX;
#pragma unroll
              for (int k = 0; k < 4; ++k) ax += wX[k] * rx[i + k];
              const unsigned ux = f2bf(siluf_(ax));
              if (i & 1) xt[i >> 1] |= ux << 16; else xt[i >> 1] = ux; }
          *(LAS v4u*)(L + XT_OFF + p * 144 + t8 * 16) = (v4u){xt[0], xt[1], xt[2], xt[3]}; }
        if (wave == 0) { const float dtv = softplusf_(DTb[(size_t)(t0 + lane) * 16 + hh] + dtb); float cs = dtv * Ah;
#pragma unroll
            for (int off = 1; off < 64; off <<= 1) { const float v = __shfl_up(cs, off); if (lane >= off) cs += v; }
            const float c63 = __shfl(cs, 63);
            SC[lane] = cs; SC[64 + lane] = __expf(cs); SC[128 + lane] = dtv * __expf(c63 - cs); SC[192 + lane] = dtv; }
        __syncthreads();
#pragma unroll
        for (int k2 = 0; k2 < 2; ++k2) { const int id = 2 * wave + k2, st = id >> 2, tt = id & 3;
            f32x4 acc = (f32x4){0.f, 0.f, 0.f, 0.f};
            if (st <= tt) {
#pragma unroll
                for (int ks = 0; ks < 4; ++ks) { const bf16x8 a = *(const LAS bf16x8*)(L + BM_OFF + (16 * st + fr) * 272 + (4 * ks + fq) * 16);
                    const bf16x8 cq = *(const LAS bf16x8*)(L + CM_OFF + (16 * tt + fr) * 272 + (4 * ks + fq) * 16);
                    acc = MFMA16(a, cq, acc); }
                const float ct = SC[16 * tt + fr];
                const f32x4 cs4 = *(const LAS f32x4*)(SC + 16 * st + 4 * fq), dt4 = *(const LAS f32x4*)(SC + 192 + 16 * st + 4 * fq);
#pragma unroll
                for (int r4 = 0; r4 < 4; ++r4) { const int sl = 16 * st + 4 * fq + r4, tl = 16 * tt + fr;
                    float v = acc[r4] * __expf(fminf(ct - cs4[r4], 0.f)) * dt4[r4];
                    if (sl == tl) v += Dh;
                    acc[r4] = (sl <= tl) ? v : 0.f; } }
            *(LAS v2u*)(L + WT_OFF + (16 * tt + fr) * 144 + (16 * st + 4 * fq) * 2) = pack4(acc); }
        __syncthreads();
        { f32x4 y[2];
          y[0] = (f32x4){0.f, 0.f, 0.f, 0.f}; y[1] = y[0];
#pragma unroll
          for (int ks = 0; ks < 4; ++ks) { const bf16x8 sa = *(const LAS bf16x8*)(L + SB_OFF + cur * 17408 + (16 * pt + fr) * 272 + (4 * ks + fq) * 16);
#pragma unroll
              for (int k2 = 0; k2 < 2; ++k2) { const bf16x8 cq = *(const LAS bf16x8*)(L + CM_OFF + (16 * (tts + k2) + fr) * 272 + (4 * ks + fq) * 16);
                  y[k2] = MFMA16(sa, cq, y[k2]); } }
#pragma unroll
          for (int k2 = 0; k2 < 2; ++k2) y[k2] = y[k2] * SC[64 + 16 * (tts + k2) + fr];
#pragma unroll
          for (int ks2 = 0; ks2 < 2; ++ks2) { const bf16x8 xa = *(const LAS bf16x8*)(L + XT_OFF + (16 * pt + fr) * 144 + (32 * ks2 + 8 * fq) * 2);
#pragma unroll
              for (int k2 = 0; k2 < 2; ++k2) if (32 * ks2 <= 16 * (tts + k2) + 15) {
                  const bf16x8 wb = *(const LAS bf16x8*)(L + WT_OFF + (16 * (tts + k2) + fr) * 144 + (32 * ks2 + 8 * fq) * 2);
                  y[k2] = MFMA16(xa, wb, y[k2]); } }
#pragma unroll
          for (int k2 = 0; k2 < 2; ++k2) { const size_t t = t0 + 16 * (tts + k2) + fr;
              const v2u zw = *(const v2u*)(Ub + t * NU + C_Z + pb);
              f32x4 z4; z4.x = __uint_as_float(zw.x << 16); z4.y = __uint_as_float(zw.x & 0xffff0000u); z4.z = __uint_as_float(zw.y << 16); z4.w = __uint_as_float(zw.y & 0xffff0000u);
              f32x4 v; v.x = y[k2].x * siluf_(z4.x); v.y = y[k2].y * siluf_(z4.y); v.z = y[k2].z * siluf_(z4.z); v.w = y[k2].w * siluf_(z4.w);
              float ss = (v.x * v.x + v.y * v.y) + (v.z * v.z + v.w * v.w);
              ss += __shfl_xor(ss, 16); ss += __shfl_xor(ss, 32);
              *(v2u*)(Yb + t * DIN + Y_C + pb) = pack4(v * nw4);
              if (fq == 0) SQb[t * NSSQ + hh * 4 + pt] = ss; } }
        { const float dec = SC[64 + 63];
#pragma unroll
          for (int i = 0; i < 4; ++i) ST[i] = ST[i] * dec;
#pragma unroll
          for (int ks2 = 0; ks2 < 2; ++ks2) { const bf16x8 ba = *(const LAS bf16x8*)(L + BT_OFF + (16 * wave + fr) * 144 + (32 * ks2 + 8 * fq) * 2);
              const f32x4 w0 = *(const LAS f32x4*)(SC + 128 + 32 * ks2 + 8 * fq), w1 = *(const LAS f32x4*)(SC + 128 + 32 * ks2 + 8 * fq + 4);
#pragma unroll
              for (int i = 0; i < 4; ++i) { const v4u xr = *(const LAS v4u*)(L + XT_OFF + (16 * i + fr) * 144 + (32 * ks2 + 8 * fq) * 2);
                  f32x4 lo, hi; lo.x = __uint_as_float(xr.x << 16) * w0.x; lo.y = __uint_as_float(xr.x & 0xffff0000u) * w0.y; lo.z = __uint_as_float(xr.y << 16) * w0.z; lo.w = __uint_as_float(xr.y & 0xffff0000u) * w0.w;
                  hi.x = __uint_as_float(xr.z << 16) * w1.x; hi.y = __uint_as_float(xr.z & 0xffff0000u) * w1.y; hi.z = __uint_as_float(xr.w << 16) * w1.z; hi.w = __uint_as_float(xr.w & 0xffff0000u) * w1.w;
                  ST[i] = MFMA16(ba, pack8(lo, hi), ST[i]); } }
#pragma unroll
          for (int i = 0; i < 4; ++i) *(LAS v2u*)(L + SB_OFF + (cur ^ 1) * 17408 + (16 * i + fr) * 272 + (16 * wave + 4 * fq) * 2) = pack4(ST[i]); }
        __syncthreads();
    }
}
__device__ __forceinline__ void lru_unit2(Frame& F, KA A, int l, int b, int hd) {
    constexpr int WAT_OFF = 0, WXT_OFF = 9216, XB_OFF = 18432, XA_OFF = 27648, AA_OFF = 44288, BB_OFF = 60672;
    LAS unsigned char* L = F.lds + RING_OFF;
    LAS float* XA = (LAS float*)(L + XA_OFF); LAS float* AA = (LAS float*)(L + AA_OFF); LAS float* BB = (LAS float*)(L + BB_OFF);
    const int tid = F.tid, lane = F.lane, wave = F.wave, fr = lane & 15, fq = lane >> 4;
    const int c0 = hd * 64;
    { const float* wa = A->in[I_LWA] + (size_t)(l * 8 + hd) * 4096; const float* wx = A->in[I_LWX] + (size_t)(l * 8 + hd) * 4096;
      for (int e = tid; e < 4096; e += NTHREADS) { const int i = e >> 6, jj = e & 63;
          *(LAS bf16*)(L + WAT_OFF + jj * 144 + i * 2) = (bf16)f2bf(wa[e]); *(LAS bf16*)(L + WXT_OFF + jj * 144 + i * 2) = (bf16)f2bf(wx[e]); } }
    const int j = tid & 63;
    float cw[4];
#pragma unroll
    for (int k = 0; k < 4; ++k) cw[k] = A->in[I_LCW][(size_t)(l * 4 + k) * 512 + c0 + j];
    const float cbias = A->in[I_LCB][(size_t)l * 512 + c0 + j];
    const int tt = wave >> 1, jts = (wave & 1) * 2;
    float ba[2], bx[2], sp[2];
#pragma unroll
    for (int k2 = 0; k2 < 2; ++k2) { const int ch = c0 + 16 * (jts + k2) + fr; ba[k2] = A->in[I_LBA][(size_t)l * 512 + ch]; bx[k2] = A->in[I_LBX][(size_t)l * 512 + ch]; sp[k2] = softplusf_(-A->in[I_LLAM][(size_t)l * 512 + ch]); }
    float hcar = 0.f;
    const bf16* Ub = P_U + (size_t)b * SEQ * NU;
    bf16* Yb = P_Y + (size_t)b * SEQ * DIN;
    __syncthreads();
    for (int tile = 0; tile < SEQ / 64; ++tile) {
        const int t0 = tile * 64;
        { float rx[11];
#pragma unroll
          for (int q = 0; q < 11; ++q) { const int ts = t0 + 8 * wave - 3 + q; rx[q] = (ts >= 0) ? bf2f(Ub[(size_t)ts * NU + C_AX + c0 + j]) : 0.f; }
#pragma unroll
          for (int i = 0; i < 8; ++i) { float a = cbias;
#pragma unroll
              for (int k = 0; k < 4; ++k) a += cw[k] * rx[i + k];
              const int t = 8 * wave + i; XA[t * 65 + j] = a; *(LAS bf16*)(L + XB_OFF + t * 144 + j * 2) = (bf16)f2bf(a); } }
        __syncthreads();
        { f32x4 ra[2], ia[2];
#pragma unroll
          for (int k2 = 0; k2 < 2; ++k2) { ra[k2] = (f32x4){0.f, 0.f, 0.f, 0.f}; ia[k2] = ra[k2]; }
#pragma unroll
          for (int ks = 0; ks < 2; ++ks) { const bf16x8 xa = *(const LAS bf16x8*)(L + XB_OFF + (16 * tt + fr) * 144 + (32 * ks + 8 * fq) * 2);
#pragma unroll
              for (int k2 = 0; k2 < 2; ++k2) { const bf16x8 wa8 = *(const LAS bf16x8*)(L + WAT_OFF + (16 * (jts + k2) + fr) * 144 + (32 * ks + 8 * fq) * 2);
                  const bf16x8 wx8 = *(const LAS bf16x8*)(L + WXT_OFF + (16 * (jts + k2) + fr) * 144 + (32 * ks + 8 * fq) * 2);
                  ra[k2] = MFMA16(xa, wa8, ra[k2]); ia[k2] = MFMA16(xa, wx8, ia[k2]); } }
#pragma unroll
          for (int k2 = 0; k2 < 2; ++k2)
#pragma unroll
              for (int r4 = 0; r4 < 4; ++r4) { const int t = 16 * tt + 4 * fq + r4, jc = 16 * (jts + k2) + fr;
                  const float rg = sigmoidf_(ra[k2][r4] + ba[k2]), ig = sigmoidf_(ia[k2][r4] + bx[k2]); const float la = -8.0f * rg * sp[k2]; const float a = __expf(la);
                  const float mult = sqrtf(fmaxf(-expm1f(2.0f * la), 0.f));
                  AA[t * 64 + jc] = a; BB[t * 64 + jc] = mult * (ig * XA[t * 65 + jc]); } }
        __syncthreads();
        if (wave == 0) {
#pragma unroll 8
            for (int t = 0; t < 64; ++t) { hcar = AA[t * 64 + lane] * hcar + BB[t * 64 + lane]; AA[t * 64 + lane] = hcar; } }
        __syncthreads();
#pragma unroll
        for (int i = 0; i < 8; ++i) { const int t = 8 * wave + i; const float gv = bf2f(Ub[(size_t)(t0 + t) * NU + C_AG + c0 + j]);
            Yb[(size_t)(t0 + t) * DIN + Y_A + c0 + j] = (bf16)f2bf(AA[t * 64 + j] * siluf_(gv)); }
        __syncthreads();
    }
}
__device__ __forceinline__ void mixer_phase2(Frame& F, KA A, int l) {
    for (int un = F.vcu; un < 224; un += F.G) {
        if (un < 128) ssd_unit(F, A, l, un >> 4, un & 15);
        else if (un < 192) lru_unit2(F, A, l, (un - 128) >> 3, (un - 128) & 7);
        else hgrn_unit(F, A, l, (un - 192) >> 2, (un - 192) & 3);
        __syncthreads();
    }
}
constexpr int NPHASES = 2 + 5 * DEPTH;
#ifndef MK_ONE_LAUNCH
#define MK_ONE_LAUNCH 1
#endif
__global__ void __launch_bounds__(NTHREADS, 2) hybrid_fwd(Args args) {
    extern __shared__ __attribute__((aligned(16))) unsigned char lds[];
    const KA Ak = (KA)__builtin_amdgcn_kernarg_segment_ptr();
    for (int u = threadIdx.x; u < (LDS_BYTES - LDSCTL_OFF) / 4; u += NTHREADS) ((LAS unsigned*)((LAS unsigned char*)lds + LDSCTL_OFF))[u] = 0u;
    __syncthreads();
    const int lo = Ak->ph_lo, hi = Ak->ph_hi;
    XcdBarrier bar; bar.bar = (unsigned*)(Ak->ws + WS_CTL) + CW_BAR; bar.x = 0; bar.st = nullptr;
    if (hi - lo > 1) bar = xcd_barrier_post((unsigned*)(Ak->ws + WS_CTL) + CW_BAR, (volatile LAS unsigned*)((LAS unsigned char*)lds + MISC_OFF) + 8);

    for (int ph = lo; ph < hi; ++ph) {
        KA A = Ak; asm volatile("" : "+s"(A));
        Frame F;
        { int tid = threadIdx.x; asm volatile("" : "+v"(tid)); F.tid = tid; F.lane = tid & 63; F.wave = __builtin_amdgcn_readfirstlane(tid >> 6); }
        { int G = gridDim.x, bx = blockIdx.x; asm volatile("" : "+s"(G), "+s"(bx)); F.G = G; F.bx = bx; F.vcu = (G % 8 == 0) ? (bx % 8) * (G / 8) + bx / 8 : bx; }
        { unsigned lb = 0; asm volatile("" : "+s"(lb)); F.lds = (LAS unsigned char*)lds + lb; }
        if (ph == 0) p0_prologue(F, A);
        else if (ph == 1) norm_phase(F, A, A->in[I_X], 0);
        else {
            const int l = (ph - 2) / 5, sub = (ph - 2) % 5;
            if (sub == 0) {
                pg8::Gemm g{P_H, P_WIN + (size_t)l * NIN_PAD * DM, M, NIN_PAD, DM}; pg8::StaticOrder S; S.init(M, NIN_PAD, F.G, F.bx);
                pg8::EpiU E{P_U, NU, P_DT, NU / 256};
                pg8::gemm_phase<pg8::EpiU, pg8::StaticOrder, true, true>(F.lds + RING_OFF, g, S, E, F.tid);
            } else if (sub == 1) {
                mixer_phase2(F, A, l);
            } else if (sub == 2) {
                ynorm_phase(F, A);
            } else if (sub == 3) {
                pg8::Gemm g{P_Y, P_WOUT + (size_t)l * DM * DIN, M, DM, DIN}; pg8::StaticOrder S; S.init(M, DM, F.G, F.bx);
                pg8::EpiResid E{l == 0 ? A->in[I_X] : A->out, A->out, DM, P_MOD + (size_t)l * BATCH * 3 * DM + 2 * DM, 3 * DM, SEQ};
                pg8::gemm_phase<pg8::EpiResid, pg8::StaticOrder, true, true>(F.lds + RING_OFF, g, S, E, F.tid);
            } else {
                if (l + 1 < DEPTH) norm_phase(F, A, A->out, l + 1); else final_norm_phase(F, A);
            }
        }
        if (ph + 1 < hi) xcd_barrier(bar);
    }
}

extern "C" void kernel_launch(void* const* d_in, const int* in_sizes, int n_in, void* d_out, int out_size, void* d_ws, size_t ws_size, hipStream_t stream) {
    static int grid = 0;
    if (grid == 0) {
        if (n_in != 23 || in_sizes[0] != M * DM || out_size != M * DM || ws_size < WS_END) { fprintf(stderr, "kernel_launch: unexpected shapes: n_in %d in0 %d out %d ws %zu (need %zu)\n", n_in, n_in > 0 ? in_sizes[0] : -1, out_size, ws_size, (size_t)WS_END); grid = -1; return; }
        int dev = 0, cus = 0, per_cu = 0;
        if (hipGetDevice(&dev) != hipSuccess || hipDeviceGetAttribute(&cus, hipDeviceAttributeMultiprocessorCount, dev) != hipSuccess) { grid = -1; return; }
        if (hipFuncSetAttribute((const void*)hybrid_fwd, hipFuncAttributeMaxDynamicSharedMemorySize, LDS_BYTES) != hipSuccess) { fprintf(stderr, "kernel_launch: hipFuncSetAttribute failed\n"); grid = -1; return; }
        if (hipOccupancyMaxActiveBlocksPerMultiprocessor(&per_cu, (const void*)hybrid_fwd, NTHREADS, LDS_BYTES) != hipSuccess || per_cu < 1)
            fprintf(stderr, "kernel_launch: note: occupancy query reports %d workgroups per CU\n", per_cu);
        (void)hipGetLastError();
        grid = cus;
    }
    if (grid < 0) return;
    if (hipMemsetAsync((char*)d_ws + WS_CTL, 0, CTL_ZERO_BYTES, stream) != hipSuccess) return;
    Args a{};
    for (int i = 0; i < 23; ++i) a.in[i] = (const float*)d_in[i];
    a.out = (float*)d_out; a.ws = (unsigned char*)d_ws;
#if MK_ONE_LAUNCH
    a.ph_lo = 0; a.ph_hi = NPHASES;
    hipLaunchKernelGGL(hybrid_fwd, dim3(grid), dim3(NTHREADS), LDS_BYTES, stream, a);
#else
    for (int ph = 0; ph < NPHASES; ++ph) { a.ph_lo = ph; a.ph_hi = ph + 1; hipLaunchKernelGGL(hybrid_fwd, dim3(grid), dim3(NTHREADS), LDS_BYTES, stream, a); }
#endif
}
```

```cpp
#include <hip/hip_runtime.h>
#include <cstdio>
#include <cstdint>
#include <cmath>
namespace pg8 {
#define PG8_LAS __attribute__((address_space(3)))
typedef unsigned short bf16_t;
typedef short bf16x8 __attribute__((ext_vector_type(8)));
typedef float f32x4 __attribute__((ext_vector_type(4)));
typedef unsigned u32x4 __attribute__((ext_vector_type(4)));
constexpr int BM = 256, BK = 64, HALF = 128, HTB = HALF * BK * 2  , STAGE_BYTES = 8 * HTB, NXCD = 8, WGM = 8;

__host__ __device__ __forceinline__ int lds_byte(int r, int c) { const int st = (r >> 4) * 2 + (c >> 5), rr = r & 15, cc = c & 31, ob = rr * 64 + cc * 2; return st * 1024 + (ob ^ (((ob >> 9) & 1) << 5)); }
__host__ __device__ __forceinline__ void stage_rc(int b, int& R, int& C) { const int st = b / 1024, sb = b % 1024, swz = sb ^ (((sb >> 9) & 1) << 5); R = (st >> 1) * 16 + swz / 64; C = (st & 1) * 32 + (swz % 64) / 2; }
__host__ __device__ __forceinline__ int perm32(int rho) { const int n = rho >> 4, i = rho & 15; return 8 * (i >> 2) + 4 * n + (i & 3); }

struct Unit { int pm, pn; };
struct Gemm { const bf16_t* A; const bf16_t* Bt; int M, N, K; };

struct StaticOrder {
    int nM, nN, nwg, G, c;
    __host__ __device__ void init(int M, int N, int G_, int c_) { nM = M / BM; nN = N / BM; nwg = nM * nN; G = G_; c = c_; }
    __host__ __device__ bool next(int i, Unit& u) const {
        const long L = (long)i * G + c; if (L >= nwg) return false;
        int wgid = (int)L; { const int q = nwg / NXCD, r = nwg % NXCD, xcd = wgid % NXCD, off = wgid / NXCD; wgid = (xcd < r ? xcd * (q + 1) : r * (q + 1) + (xcd - r) * q) + off; }
        const int nig = WGM * nN, gid = wgid / nig, fm = gid * WGM, gsz = (nM - fm) < WGM ? (nM - fm) : WGM;
        u.pm = fm + ((wgid % nig) % gsz); u.pn = (wgid % nig) / gsz; return true;
    }
    __device__ __forceinline__ void a_ready(const Unit&) const {}
    __device__ __forceinline__ void done(const Unit&) const {}
};

__device__ __forceinline__ unsigned cvt_pk_bf16(float lo, float hi) { unsigned r; asm volatile("v_cvt_pk_bf16_f32 %0, %1, %2" : "=v"(r) : "v"(lo), "v"(hi)); return r; }

__device__ __forceinline__ float epi_sig(float x) { return 1.0f / (1.0f + __expf(-x)); }
struct EpiU {
    static constexpr bool PERM = true, AFTER_DRAIN = false;
    bf16_t* U; int ldu; float* DT; int n_full; const float* lb; const float* dtb;
    __device__ __forceinline__ void operator()(const f32x4 (&acc)[2][2][4][2], const Unit& u, int wr, int wc, int fr, int fq) const {
        const int row0 = u.pm * BM + wr * 64 + fr;
        if (u.pn < n_full) {
            const int col0 = u.pn * BM + wc * 32 + 8 * fq;
            const int mode = (u.pn < 2 || u.pn == 8 || u.pn == 9 || u.pn >= 16) ? 0 : ((u.pn == 6 || u.pn == 7) ? 2 : 1);
#pragma unroll
            for (int bj = 0; bj < 2; ++bj) {
                f32x4 l0 = (f32x4){0.f, 0.f, 0.f, 0.f}, l1 = l0;
                if (mode == 2) { const float* lp = lb + (col0 + bj * HALF - 1536); l0 = *(const f32x4*)lp; l1 = *(const f32x4*)(lp + 4); }
#pragma unroll
                for (int ai = 0; ai < 2; ++ai)
#pragma unroll
                    for (int m = 0; m < 4; ++m) { bf16_t* rowp = U + (size_t)(row0 + ai * HALF + m * 16) * ldu + col0;
                        f32x4 v0 = acc[ai][bj][m][0], v1 = acc[ai][bj][m][1];
                        if (mode == 1) {
#pragma unroll
                            for (int i = 0; i < 4; ++i) { v0[i] = v0[i] * epi_sig(v0[i]); v1[i] = v1[i] * epi_sig(v1[i]); }
                        } else if (mode == 2) {
#pragma unroll
                            for (int i = 0; i < 4; ++i) { v0[i] = __logf(l0[i] + (1.f - l0[i]) * epi_sig(v0[i])); v1[i] = __logf(l1[i] + (1.f - l1[i]) * epi_sig(v1[i])); }
                        }
                        u32x4 w; w.x = cvt_pk_bf16(v0[0], v0[1]); w.y = cvt_pk_bf16(v0[2], v0[3]); w.z = cvt_pk_bf16(v1[0], v1[1]); w.w = cvt_pk_bf16(v1[2], v1[3]);
                        *(u32x4*)(rowp + bj * HALF) = w; } }
        } else if (wc == 0 && fq < 2) {
            const f32x4 b0 = *(const f32x4*)(dtb + 8 * fq), b1 = *(const f32x4*)(dtb + 8 * fq + 4);
#pragma unroll
            for (int ai = 0; ai < 2; ++ai)
#pragma unroll
                for (int m = 0; m < 4; ++m) { float* rowp = DT + (size_t)(row0 + ai * HALF + m * 16) * 16 + 8 * fq;
                    f32x4 v0 = acc[ai][0][m][0] + b0, v1 = acc[ai][0][m][1] + b1;
#pragma unroll
                    for (int i = 0; i < 4; ++i) { v0[i] = v0[i] > 20.f ? v0[i] : log1pf(__expf(v0[i])); v1[i] = v1[i] > 20.f ? v1[i] : log1pf(__expf(v1[i])); }
                    *(f32x4*)(rowp) = v0; *(f32x4*)(rowp + 4) = v1; }
        }
    }
};
struct EpiResid {
    static constexpr bool PERM = false, AFTER_DRAIN = false;
    const float* base; float* out; int ldc; const float* gate; int gate_stride; int rows_per_batch;
    __device__ __forceinline__ void operator()(const f32x4 (&acc)[2][2][4][2], const Unit& u, int wr, int wc, int fr, int fq) const {
        const int row0 = u.pm * BM + wr * 64 + fr, col0 = u.pn * BM + wc * 32 + 4 * fq;
        const float* gp = gate + (size_t)((u.pm * BM) / rows_per_batch) * gate_stride + col0;
        f32x4 gv[2][2];
#pragma unroll
        for (int bj = 0; bj < 2; ++bj)
#pragma unroll
            for (int n = 0; n < 2; ++n) gv[bj][n] = *(const f32x4*)(gp + bj * HALF + n * 16);
#pragma unroll
        for (int ai = 0; ai < 2; ++ai)
#pragma unroll
            for (int m = 0; m < 4; ++m) { const size_t off = (size_t)(row0 + ai * HALF + m * 16) * ldc + col0;
#pragma unroll
                for (int bj = 0; bj < 2; ++bj)
#pragma unroll
                    for (int n = 0; n < 2; ++n) { const f32x4 bs = *(const f32x4*)(base + off + bj * HALF + n * 16);
                        *(f32x4*)(out + off + bj * HALF + n * 16) = bs + gv[bj][n] * acc[ai][bj][m][n]; } }
    }
};

template <class Epi, class Sched, bool ALIGN_EPI = false, bool SP2 = false>
__device__ __forceinline__ void gemm_phase(PG8_LAS unsigned char* lds, const Gemm g, const Sched& S, const Epi& E, const int tid) {
    const int wid = __builtin_amdgcn_readfirstlane(tid >> 6), lane = tid & 63, wr = wid >> 2, wc = wid & 3, fr = lane & 15, fq = lane >> 4;
    const int K = g.K, nt = K / BK;
    unsigned voffA[2], voffB[2];
#pragma unroll
    for (int i = 0; i < 2; ++i) { int R, C; stage_rc(tid * 16 + i * 8192, R, C); const int Rb = Epi::PERM ? ((R & ~31) + perm32(R & 31)) : R;
        voffA[i] = (unsigned)(R * K + C) * 2u; voffB[i] = (unsigned)(Rb * K + C) * 2u; }
    const size_t kstep = (size_t)(BK * 2);
    const size_t hstep = (size_t)HALF * K * 2;
    const size_t tstep = 2 * hstep;
    const unsigned ldsw = (unsigned)wid * 1024u;
    const int aoff = lds_byte(wr * 64 + fr, fq * 8), boff = lds_byte(wc * 32 + fr, fq * 8);
#define PG8_SA(b, h) (((b) * 2 + (h)) * HTB)
#define PG8_SB(b, h) ((4 + (b) * 2 + (h)) * HTB)
#define PG8_STAGE(bufoff, gbase, voff) do { _Pragma("unroll") for (int _i = 0; _i < 2; ++_i) \
        __builtin_amdgcn_global_load_lds((const unsigned*)((const char*)(gbase) + (voff)[_i]), (PG8_LAS unsigned*)(lds + (bufoff) + ldsw + _i * 8192), 16, 0, 0); } while (0)
#define PG8_LDA(dst, b, h) do { _Pragma("unroll") for (int m = 0; m < 4; ++m) _Pragma("unroll") for (int k = 0; k < 2; ++k) dst[m][k] = *(const PG8_LAS bf16x8*)(lds + PG8_SA(b, h) + aoff + m * 2048 + k * 1024); } while (0)
#define PG8_LDB(dst, b, h) do { _Pragma("unroll") for (int n = 0; n < 2; ++n) _Pragma("unroll") for (int k = 0; k < 2; ++k) dst[n][k] = *(const PG8_LAS bf16x8*)(lds + PG8_SB(b, h) + boff + n * 2048 + k * 1024); } while (0)
#define PG8_MMA(ai, bj, At, Bt) do { __builtin_amdgcn_s_setprio(1); _Pragma("unroll") for (int m = 0; m < 4; ++m) _Pragma("unroll") for (int n = 0; n < 2; ++n) _Pragma("unroll") for (int k = 0; k < 2; ++k) \
        acc[ai][bj][m][n] = __builtin_amdgcn_mfma_f32_16x16x32_bf16(Bt[n][k], At[m][k], acc[ai][bj][m][n], 0, 0, 0); __builtin_amdgcn_s_setprio(0); } while (0)
#define PG8_WAIT_V(n) asm volatile("s_waitcnt vmcnt(" #n ")" ::: "memory")
#define PG8_WAIT_L(n) asm volatile("s_waitcnt lgkmcnt(" #n ")" ::: "memory")
#define PG8_BAR __builtin_amdgcn_s_barrier()
#define PG8_SCHED __builtin_amdgcn_sched_barrier(0)
    Unit cur, nxt; int ui = 0;
    if (!S.next(0, cur)) return;
    f32x4 acc[2][2][4][2];
#pragma unroll
    for (int a = 0; a < 2; ++a)
#pragma unroll
        for (int b = 0; b < 2; ++b)
#pragma unroll
            for (int m = 0; m < 4; ++m)
#pragma unroll
                for (int n = 0; n < 2; ++n) acc[a][b][m][n] = (f32x4){0.f, 0.f, 0.f, 0.f};
    bf16x8 At[4][2], B0[2][2], B1[2][2];
    const char* cA = (const char*)g.A + (size_t)cur.pm * tstep; const char* cB = (const char*)g.Bt + (size_t)cur.pn * tstep;
    S.a_ready(cur);
    if constexpr (SP2) {
        PG8_STAGE(PG8_SB(0, 0), cB, voffB); PG8_STAGE(PG8_SB(0, 1), cB + hstep, voffB); PG8_STAGE(PG8_SA(0, 0), cA, voffA); PG8_STAGE(PG8_SA(0, 1), cA + hstep, voffA);
        if (wr == 1) PG8_BAR;
        PG8_WAIT_V(2); PG8_BAR;
        PG8_STAGE(PG8_SB(1, 0), cB + kstep, voffB); PG8_STAGE(PG8_SA(1, 0), cA + kstep, voffA); PG8_STAGE(PG8_SB(1, 1), cB + hstep + kstep, voffB);
        PG8_WAIT_V(6); PG8_BAR;
    } else {
        PG8_STAGE(PG8_SB(0, 0), cB, voffB); PG8_STAGE(PG8_SA(0, 0), cA, voffA); PG8_STAGE(PG8_SB(0, 1), cB + hstep, voffB); PG8_STAGE(PG8_SA(0, 1), cA + hstep, voffA);
        if (wr == 1) PG8_BAR;
        PG8_WAIT_V(4); PG8_BAR;
        PG8_STAGE(PG8_SB(1, 0), cB + kstep, voffB); PG8_STAGE(PG8_SA(1, 0), cA + kstep, voffA); PG8_STAGE(PG8_SB(1, 1), cB + hstep + kstep, voffB);
        PG8_WAIT_V(6); PG8_BAR;
    }
    for (;;) {
        const bool has_next = S.next(ui + 1, nxt);
        const char* nA = has_next ? (const char*)g.A + (size_t)nxt.pm * tstep : cA; const char* nB = has_next ? (const char*)g.Bt + (size_t)nxt.pn * tstep : cB;
        for (int t = 0; t < nt; t += 2) {
            const bool last = (t == nt - 2);
            const char* a1 = cA + (size_t)(t + 1) * kstep;
            const char* a2 = last ? nA : cA + (size_t)(t + 2) * kstep; const char* b2 = last ? nB : cB + (size_t)(t + 2) * kstep;
            const char* a3 = a2 + kstep; const char* b3 = b2 + kstep;
            if (last && has_next) S.a_ready(nxt);
            if constexpr (SP2) {
            PG8_LDB(B0, 0, 0); PG8_LDB(B1, 0, 1); PG8_SCHED; PG8_LDA(At, 0, 0); PG8_STAGE(PG8_SA(1, 1), a1 + hstep, voffA);
            PG8_WAIT_V(8); PG8_WAIT_L(0); PG8_BAR; PG8_MMA(0, 0, At, B0); PG8_MMA(0, 1, At, B1); PG8_BAR; PG8_SCHED;
            PG8_LDA(At, 0, 1); PG8_STAGE(PG8_SB(0, 0), b2, voffB); PG8_STAGE(PG8_SB(0, 1), b2 + hstep, voffB); PG8_STAGE(PG8_SA(0, 0), a2, voffA);
            PG8_WAIT_V(8); PG8_WAIT_L(0); PG8_BAR; PG8_MMA(1, 0, At, B0); PG8_MMA(1, 1, At, B1); PG8_BAR; PG8_SCHED;
            PG8_LDB(B0, 1, 0); PG8_LDB(B1, 1, 1); PG8_SCHED; PG8_LDA(At, 1, 0); PG8_STAGE(PG8_SA(0, 1), a2 + hstep, voffA);
            PG8_WAIT_V(8); PG8_WAIT_L(0); PG8_BAR; PG8_MMA(0, 0, At, B0); PG8_MMA(0, 1, At, B1); PG8_BAR; PG8_SCHED;
            PG8_LDA(At, 1, 1); PG8_STAGE(PG8_SB(1, 0), b3, voffB); PG8_STAGE(PG8_SB(1, 1), b3 + hstep, voffB); PG8_STAGE(PG8_SA(1, 0), a3, voffA);
            PG8_WAIT_V(8); PG8_WAIT_L(0); PG8_BAR; PG8_MMA(1, 0, At, B0); PG8_MMA(1, 1, At, B1); PG8_BAR; PG8_SCHED;
            } else {
            PG8_LDB(B0, 0, 0); PG8_SCHED; PG8_LDA(At, 0, 0); PG8_STAGE(PG8_SA(1, 1), a1 + hstep, voffA);
            PG8_WAIT_L(8); PG8_BAR; PG8_WAIT_L(0); PG8_MMA(0, 0, At, B0); PG8_BAR; PG8_SCHED;
            PG8_LDB(B1, 0, 1); PG8_STAGE(PG8_SB(0, 0), b2, voffB);
            PG8_BAR; PG8_WAIT_L(0); PG8_MMA(0, 1, At, B1); PG8_BAR;
            PG8_LDA(At, 0, 1); PG8_STAGE(PG8_SA(0, 0), a2, voffA);
            PG8_BAR; PG8_WAIT_L(0); PG8_MMA(1, 0, At, B0); PG8_BAR; PG8_SCHED;
            PG8_STAGE(PG8_SB(0, 1), b2 + hstep, voffB);
            PG8_WAIT_V(6); PG8_BAR; PG8_MMA(1, 1, At, B1); PG8_BAR;
            PG8_LDB(B0, 1, 0); PG8_SCHED; PG8_LDA(At, 1, 0); PG8_STAGE(PG8_SA(0, 1), a2 + hstep, voffA);
            PG8_WAIT_L(8); PG8_BAR; PG8_WAIT_L(0); PG8_MMA(0, 0, At, B0); PG8_BAR; PG8_SCHED;
            PG8_LDB(B1, 1, 1); PG8_STAGE(PG8_SB(1, 0), b3, voffB);
            PG8_BAR; PG8_WAIT_L(0); PG8_MMA(0, 1, At, B1); PG8_BAR;
            PG8_LDA(At, 1, 1); PG8_STAGE(PG8_SA(1, 0), a3, voffA);
            PG8_BAR; PG8_WAIT_L(0); PG8_MMA(1, 0, At, B0); PG8_BAR; PG8_SCHED;
            PG8_STAGE(PG8_SB(1, 1), b3 + hstep, voffB);
            PG8_WAIT_V(6); PG8_BAR; PG8_MMA(1, 1, At, B1); PG8_BAR;
            }
        }
        if constexpr (ALIGN_EPI) { if (wr == 0) PG8_BAR; }
        if constexpr (!Epi::AFTER_DRAIN) { E(acc, cur, wr, wc, fr, fq); S.done(cur); }
        if (!has_next) break;
#pragma unroll
        for (int a = 0; a < 2; ++a)
#pragma unroll
            for (int b = 0; b < 2; ++b)
#pragma unroll
                for (int m = 0; m < 4; ++m)
#pragma unroll
                    for (int n = 0; n < 2; ++n) acc[a][b][m][n] = (f32x4){0.f, 0.f, 0.f, 0.f};
        cur = nxt; cA = nA; cB = nB; ++ui;
        if constexpr (ALIGN_EPI) { if (wr == 1) PG8_BAR; }
    }
    PG8_WAIT_V(0);
    if constexpr (!ALIGN_EPI) { if (wr == 0) PG8_BAR; }
    PG8_BAR;
    if constexpr (Epi::AFTER_DRAIN) { E.fused(acc, cur, wr, wc, fr, fq, lds, wid, lane); S.done(cur); }
#undef PG8_SA
#undef PG8_SB
#undef PG8_STAGE
#undef PG8_LDA
#undef PG8_LDB
#undef PG8_MMA
#undef PG8_WAIT_V
#undef PG8_WAIT_L
#undef PG8_BAR
#undef PG8_SCHED
}
}
#ifndef PROBE_OFS
#define PROBE_OFS 0.0f
#endif
#ifndef PROBE_TS
#define PROBE_TS 0
#endif
#ifndef PROBE_VCU
#define PROBE_VCU 0
#endif
#ifndef DUP_MASK
#define DUP_MASK 0
#endif
constexpr int NWAVES = 8, NTHREADS = 512;
constexpr int BATCH = 8, SEQ = 2048, DM = 1024, DEPTH = 4, M = BATCH * SEQ;
constexpr int NIN = 5648, NU = 5632, NIN_PAD = 5888, DIN = 2048;
constexpr int C_AX = 0, C_AG = 512, C_HQ = 1024, C_HF = 1536, C_HI = 2048, C_HG = 2560, C_Z = 3072, C_XBC = 4096, C_B = 5120, C_C = 5376;
constexpr int Y_A = 0, Y_B = 512, Y_C = 1024;
constexpr float EPS = 1e-6f;
constexpr int NSSQ = 96;

constexpr size_t MiB = 1u << 20;
constexpr size_t WS_CTL = 0, CTL_ZERO_BYTES = 1 * MiB;
constexpr size_t WS_WIN = 2 * MiB;
constexpr size_t WS_WOUT = 48 * MiB;
constexpr size_t WS_MOD = 64 * MiB;
constexpr size_t WS_LB = 64 * MiB + 512 * 1024;
constexpr size_t WS_DT = 65 * MiB;
constexpr size_t WS_SSQ = 340 * MiB;
constexpr size_t WS_H = 68 * MiB;
constexpr size_t WS_BC = WS_H;
constexpr size_t WS_Y = 100 * MiB;
constexpr size_t WS_U = 164 * MiB;
constexpr size_t WS_END = 346 * MiB;
static_assert(WS_WIN + (size_t)DEPTH * NIN_PAD * DM * 2 <= WS_WOUT && WS_WOUT + (size_t)DEPTH * DM * DIN * 2 <= WS_MOD && WS_U + (size_t)M * NU * 2 <= WS_SSQ && WS_SSQ + (size_t)M * NSSQ * 4 <= WS_END, "d_ws map");
constexpr int CW_BAR = 4096;

constexpr int RING_OFF = 0, RING_BYTES = 131072;
constexpr int LDSCTL_OFF = RING_BYTES, MISC_OFF = LDSCTL_OFF + 320;
constexpr int LDS_BYTES = 147456;

#define GAS __attribute__((address_space(1)))
#define LAS __attribute__((address_space(3)))
typedef unsigned short bf16;
typedef unsigned v4u __attribute__((ext_vector_type(4)));
typedef float f32x4 __attribute__((ext_vector_type(4)));
typedef short bf16x8 __attribute__((ext_vector_type(8)));
typedef GAS unsigned gu32;
typedef GAS unsigned long long gu64;
#define RLX_AGENT __ATOMIC_RELAXED, __HIP_MEMORY_SCOPE_AGENT
#define LDS_WAIT() asm volatile("s_waitcnt lgkmcnt(0)" ::: "memory")
#define VM_WAIT() asm volatile("s_waitcnt vmcnt(0)" ::: "memory")
__device__ __forceinline__ unsigned long long rt() { return __builtin_amdgcn_s_memrealtime(); }
typedef float f32x2_t __attribute__((ext_vector_type(2))); typedef __bf16 bf16x2_t __attribute__((ext_vector_type(2)));
__device__ __forceinline__ unsigned pk2(float lo, float hi) { f32x2_t v = {lo, hi}; bf16x2_t b = __builtin_convertvector(v, bf16x2_t); return __builtin_bit_cast(unsigned, b); }
__device__ __forceinline__ unsigned f2bf(float f) { return pk2(f, 0.f) & 0xffffu; }

#define XB_TMO      128
#define XB_XCNT(j)  (256  + 64 * (j))
#define XB_XSUB(j)  (1280 + 64 * (j))
#define XB_XGEN(j)  (2304 + 64 * (j))
#define XB_TOP      3328
#define XB_TOPGEN   3392
#define XCD_BAR_WORDS 3456
#define XB_SPIN_CAP (1u << 18)

__device__ __forceinline__ unsigned xb_ld(unsigned* p)              { return __hip_atomic_load(p, __ATOMIC_RELAXED, __HIP_MEMORY_SCOPE_AGENT); }
__device__ __forceinline__ unsigned xb_add(unsigned* p, unsigned v) { return __hip_atomic_fetch_add(p, v, __ATOMIC_RELAXED, __HIP_MEMORY_SCOPE_AGENT); }
__device__ __forceinline__ unsigned xb_xcc_id() { return (unsigned)__builtin_amdgcn_s_getreg((3 << 11) | 20) & 0xFu; }
#define XB_SPIN(cond, bar) do { unsigned _sp = 0; while (cond) { __builtin_amdgcn_s_sleep(1); \
    if ((++_sp & 255u) == 0u) { if (xb_ld(&(bar)[XB_TMO])) break; if (_sp > XB_SPIN_CAP) { atomicAdd(&(bar)[XB_TMO], 1u); break; } } } } while (0)

struct XcdBarrier {
    unsigned* bar; unsigned x;
    volatile LAS unsigned* st;
};

__device__ __forceinline__ XcdBarrier xcd_barrier_post(unsigned* bar, volatile LAS unsigned* st) {
    XcdBarrier b; b.bar = bar; b.x = xb_xcc_id(); b.st = st;
    if (threadIdx.x == 0) (void)xb_add(&bar[XB_XCNT(b.x)], 1u);
    return b;
}
__device__ __forceinline__ void xcd_barrier_complete(unsigned* bar, unsigned x, unsigned& nloc, unsigned& nx) {
    const unsigned G = gridDim.x * gridDim.y * gridDim.z;
    unsigned sum, cnt, mine, sp = 0u;
    for (;;) {
        sum = 0u; cnt = 0u; mine = 0u;
#pragma unroll
        for (unsigned j = 0; j < 16; ++j) { const unsigned c = xb_ld(&bar[XB_XCNT(j)]); sum += c; cnt += (c > 0u) ? 1u : 0u; mine = (j == x) ? c : mine; }
        if (sum == G) break;
        __builtin_amdgcn_s_sleep(1);
        if ((++sp & 255u) == 0u) { if (xb_ld(&bar[XB_TMO])) break; if (sp > XB_SPIN_CAP) { atomicAdd(&bar[XB_TMO], 1u); break; } }
    }
    nloc = mine > 0u ? mine : 1u; nx = cnt > 0u ? cnt : 1u;
}

__device__ __forceinline__ void xcd_barrier(const XcdBarrier& b) {
    asm volatile("s_waitcnt vmcnt(0)" ::: "memory");
    __syncthreads();
    if (threadIdx.x == 0) {
        unsigned* bar = b.bar;
        __builtin_amdgcn_s_waitcnt(0);
        unsigned nloc = b.st[0], nx = b.st[1];
        if (nloc == 0u) { xcd_barrier_complete(bar, b.x, nloc, nx); b.st[0] = nloc; b.st[1] = nx; }
        const unsigned old = xb_add(&bar[XB_XSUB(b.x)], 1u);
        const unsigned gen = old / nloc;
        if (old + 1u == (gen + 1u) * nloc) {
            __builtin_amdgcn_fence(__ATOMIC_RELEASE, "agent");
            asm volatile("s_waitcnt vmcnt(0)" ::: "memory");
            const unsigned og = xb_add(&bar[XB_TOP], 1u);
            const unsigned tg = og / nx;
            if (og + 1u == (tg + 1u) * nx) xb_add(&bar[XB_TOPGEN], 1u);
            else XB_SPIN(xb_ld(&bar[XB_TOPGEN]) == tg, bar);
            __builtin_amdgcn_fence(__ATOMIC_ACQUIRE, "agent");
            xb_add(&bar[XB_XGEN(b.x)], 1u);
            asm volatile("s_waitcnt vmcnt(0)" ::: "memory");
        } else {
            XB_SPIN(xb_ld(&bar[XB_XGEN(b.x)]) == gen, bar);
            __builtin_amdgcn_fence(__ATOMIC_ACQUIRE, "agent");
            asm volatile("s_waitcnt vmcnt(0)" ::: "memory");
        }
    }
    __syncthreads();
}
struct Frame {
    LAS unsigned char* lds;
    int tid, lane, wave;
    int vcu, G, bx;
};
struct Args { const float* in[23]; float* out; unsigned char* ws; int ph_lo, ph_hi; };
typedef const __attribute__((address_space(4))) Args* KA;
#define P_WIN  ((bf16*)(A->ws + WS_WIN))
#define P_WOUT ((bf16*)(A->ws + WS_WOUT))
#define P_H    ((bf16*)(A->ws + WS_H))
#define P_Y    ((bf16*)(A->ws + WS_Y))
#define P_U    ((bf16*)(A->ws + WS_U))
#define P_MOD  ((float*)(A->ws + WS_MOD))
#define P_DT   ((float*)(A->ws + WS_DT))
#define P_SSQ  ((float*)(A->ws + WS_SSQ))
#define P_LB   ((float*)(A->ws + WS_LB))
enum { I_X = 0, I_C, I_NORMW, I_WADA, I_BADA, I_WIN, I_LCW, I_LCB, I_LWA, I_LBA, I_LWX, I_LBX, I_LLAM, I_HGLB, I_HGNW, I_SCW, I_SCB, I_SDTB, I_SALOG, I_SD, I_SNW, I_WOUT, I_FNW };

__device__ __forceinline__ float bf2f(bf16 h) { return __uint_as_float((unsigned)h << 16); }
__device__ __forceinline__ float sigmoidf_(float x) { return 1.0f / (1.0f + __expf(-x)); }
__device__ __forceinline__ float siluf_(float x) { return x * sigmoidf_(x); }
__device__ __forceinline__ float softplusf_(float x) { return x > 20.f ? x : log1pf(__expf(x)); }
__device__ __forceinline__ float wave_sum(float v) {
#pragma unroll
    for (int o = 1; o < 64; o <<= 1) v += __shfl_xor(v, o);
    return v;
}

__device__ __forceinline__ void p0_transpose_item(const float* W, int K, int N, bf16* WT, LAS float* scr, int item, int lane) {
    const int nblk = (N + 31) / 32, kb = item / nblk, nb = item % nblk, k0 = 64 * kb, n0 = 32 * nb;
    const int nn = n0 + (lane & 31); const bool okc = nn < N;
#pragma unroll 8
    for (int i = 0; i < 32; ++i) { const int kk = 2 * i + (lane >> 5); scr[kk * 33 + (lane & 31)] = okc ? W[(size_t)(k0 + kk) * N + nn] : 0.f; }
    LDS_WAIT(); asm volatile("" ::: "memory");
    const int c = lane & 7;
#pragma unroll
    for (int j = 0; j < 4; ++j) { const int n = (lane >> 3) + 8 * j; const LAS float* s = scr + (8 * c) * 33 + n;
        v4u o; o.x = pk2(s[0 * 33], s[1 * 33]); o.y = pk2(s[2 * 33], s[3 * 33]); o.z = pk2(s[4 * 33], s[5 * 33]); o.w = pk2(s[6 * 33], s[7 * 33]);
        *(GAS v4u*)(WT + (size_t)(n0 + n) * K + k0 + 8 * c) = o; }
    LDS_WAIT(); asm volatile("" ::: "memory");
}

__device__ __forceinline__ void p0_prologue(Frame& F, KA A) {
    {
        LAS float* scr = (LAS float*)(F.lds + RING_OFF + F.wave * 16384);
        const int gw = F.vcu * NWAVES + F.wave, NGW = F.G * NWAVES;
        constexpr int I_IN = (DM / 64) * ((NIN + 31) / 32), I_OUT = (DIN / 64) * (DM / 32), I_ZERO = (NIN_PAD - 5664) * DM * 2 / 1024;
        constexpr int PER_L = I_IN + I_OUT + I_ZERO, NITEMS = DEPTH * PER_L;
        for (int it = gw; it < NITEMS; it += NGW) {
            const int l = it / PER_L; int r = it % PER_L;
            bf16* win = P_WIN + (size_t)l * NIN_PAD * DM; bf16* wout = P_WOUT + (size_t)l * DM * DIN;
            if (r < I_IN) { p0_transpose_item(A->in[I_WIN] + (size_t)l * DM * NIN, DM, NIN, win, scr, r, F.lane); continue; } r -= I_IN;
            if (r < I_OUT) { p0_transpose_item(A->in[I_WOUT] + (size_t)l * DIN * DM, DIN, DM, wout, scr, r, F.lane); continue; } r -= I_OUT;
            *(GAS v4u*)((unsigned char*)(win + (size_t)5664 * DM) + (size_t)r * 1024 + F.lane * 16) = (v4u){0u, 0u, 0u, 0u};
        }
    }
    __syncthreads();
    if (F.vcu == F.G - 1) {
        const int c = F.tid;
        float lg[4], mx = -1e30f;
#pragma unroll
        for (int q = 0; q < 4; ++q) { lg[q] = A->in[I_HGLB][(size_t)q * 512 + c]; mx = fmaxf(mx, lg[q]); }
        float sum = 0.f;
#pragma unroll
        for (int q = 0; q < 4; ++q) { lg[q] = __expf(lg[q] - mx); sum += lg[q]; }
        float run = 0.f; P_LB[c] = 0.f;
#pragma unroll
        for (int q = 1; q < 4; ++q) { run += lg[q] / sum; P_LB[q * 512 + c] = run; }
    }
    {
        LAS float* part = (LAS float*)(F.lds + RING_OFF);
        const float* cc = A->in[I_C];
        for (int un = F.vcu; un < DEPTH * 48; un += F.G) {
            const int l = un / 48, n0 = (un % 48) * 64;
            const float* w = A->in[I_WADA] + (size_t)l * DM * 3 * DM + n0 + F.lane;
            float acc[8];
#pragma unroll
            for (int b = 0; b < 8; ++b) acc[b] = 0.f;
            for (int k = F.wave * 128; k < F.wave * 128 + 128; ++k) {
                const float wv = w[(size_t)k * 3 * DM];
#pragma unroll
                for (int b = 0; b < 8; ++b) { const float cv = cc[b * DM + k]; acc[b] += siluf_(cv) * wv; }
            }
#pragma unroll
            for (int b = 0; b < 8; ++b) part[(F.wave * 8 + b) * 64 + F.lane] = acc[b];
            __syncthreads();
            { const int b = F.wave; float s = 0.f;
#pragma unroll
              for (int w8 = 0; w8 < 8; ++w8) s += part[(w8 * 8 + b) * 64 + F.lane];
              P_MOD[((size_t)l * BATCH + b) * 3 * DM + n0 + F.lane] = s + A->in[I_BADA][(size_t)l * 3 * DM + n0 + F.lane]; }
            __syncthreads();
        }
    }
}

__device__ __forceinline__ void norm_phase(Frame& F, KA A, const float* xsrc, int l) {
    const int gw = F.vcu * NWAVES + F.wave, NGW = F.G * NWAVES;
    const float* nw = A->in[I_NORMW] + (size_t)l * DM;
    for (int m = gw; m < M; m += NGW) {
        const int b = m / SEQ;
        const float* shift = P_MOD + ((size_t)l * BATCH + b) * 3 * DM; const float* scale = shift + DM;
        const GAS f32x4* xr = (const GAS f32x4*)(xsrc + (size_t)m * DM) + F.lane;
        f32x4 v[4]; float s = 0.f;
#pragma unroll
        for (int j = 0; j < 4; ++j) { v[j] = xr[64 * j]; s += (v[j].x * v[j].x + v[j].y * v[j].y) + (v[j].z * v[j].z + v[j].w * v[j].w); }
        const float inv = 1.0f / sqrtf(wave_sum(s) * (1.f / DM) + EPS);
        GAS unsigned long long* o8 = (GAS unsigned long long*)(P_H + (size_t)m * DM) + F.lane;
#pragma unroll
        for (int j = 0; j < 4; ++j) { const int k = 4 * F.lane + 256 * j;
            const f32x4 w4 = *(const f32x4*)(nw + k), sc = *(const f32x4*)(scale + k), sh = *(const f32x4*)(shift + k);
            const f32x4 hv = (v[j] * inv) * w4 * (sc + 1.0f) + sh;
            o8[64 * j] = (unsigned long long)pk2(hv.x, hv.y) | ((unsigned long long)pk2(hv.z, hv.w) << 32); }
    }
}
__device__ __forceinline__ void final_norm_phase(Frame& F, KA A) {
    const int gw = F.vcu * NWAVES + F.wave, NGW = F.G * NWAVES;
    const float* nw = A->in[I_FNW];
    for (int m = gw; m < M; m += NGW) {
        GAS f32x4* xr = (GAS f32x4*)(A->out + (size_t)m * DM) + F.lane;
        f32x4 v[4]; float s = 0.f;
#pragma unroll
        for (int j = 0; j < 4; ++j) { v[j] = xr[64 * j]; s += (v[j].x * v[j].x + v[j].y * v[j].y) + (v[j].z * v[j].z + v[j].w * v[j].w); }
        const float inv = 1.0f / sqrtf(wave_sum(s) * (1.f / DM) + EPS);
#pragma unroll
        for (int j = 0; j < 4; ++j) { const f32x4 w4 = *(const f32x4*)(nw + 4 * F.lane + 256 * j); xr[64 * j] = (v[j] * inv) * w4; }
    }
}
__device__ __forceinline__ void ynorm_phase(Frame& F, KA A) {
    const int gw = F.vcu * NWAVES + F.wave, NGW = F.G * NWAVES;
    for (int m = gw; m < M; m += NGW) {
        const float* sq = P_SSQ + (size_t)m * NSSQ;
        const float q0 = sq[F.lane], q1 = (F.lane < 32) ? sq[64 + F.lane] : 0.f;
        float sc[3];
        sc[0] = 1.0f / sqrtf(wave_sum(q1) * (1.f / 512.f) + EPS);
        sc[1] = 1.0f / sqrtf(wave_sum(F.lane < 32 ? q0 : 0.f) * (1.f / 512.f) + EPS);
        sc[2] = 1.0f / sqrtf(wave_sum(F.lane < 32 ? 0.f : q0) * (1.f / 512.f) + EPS);
        GAS v4u* yr = (GAS v4u*)(P_Y + (size_t)m * DIN + Y_B) + F.lane;
#pragma unroll
        for (int s3 = 0; s3 < 3; ++s3) { v4u w = yr[64 * s3]; const float f = sc[s3];
            w.x = pk2(__uint_as_float(w.x << 16) * f, __uint_as_float(w.x & 0xffff0000u) * f);
            w.y = pk2(__uint_as_float(w.y << 16) * f, __uint_as_float(w.y & 0xffff0000u) * f);
            w.z = pk2(__uint_as_float(w.z << 16) * f, __uint_as_float(w.z & 0xffff0000u) * f);
            w.w = pk2(__uint_as_float(w.w << 16) * f, __uint_as_float(w.w & 0xffff0000u) * f);
            yr[64 * s3] = w; }
    }
}
__device__ __forceinline__ void bc_prepass(Frame& F, KA A, int l) {
    const int tid = F.tid, n = tid & 127, tq = tid >> 7;
    const float* cwp = A->in[I_SCW] + (size_t)l * 4 * 1536; const float* cbp = A->in[I_SCB] + (size_t)l * 1536;
    for (int it = F.vcu; it < BATCH * 2 * 32; it += F.G) {
        const int chunk = it & 31, g = (it >> 5) & 1, b = it >> 6;
        const int chB = 1024 + g * 128 + n, chC = 1280 + g * 128 + n;
        float wB[4], wC[4];
#pragma unroll
        for (int k = 0; k < 4; ++k) { wB[k] = cwp[k * 1536 + chB]; wC[k] = cwp[k * 1536 + chC]; }
        const float bB = cbp[chB], bC = cbp[chC];
        const bf16* Ub = P_U + (size_t)b * SEQ * NU;
        bf16* img = (bf16*)(A->ws + WS_BC + (size_t)it * 49152);
        float rb[19], rc[19];
#pragma unroll
        for (int j = 0; j < 19; ++j) { const int ts = chunk * 64 + 16 * tq - 3 + j, tc = ts < 0 ? 0 : ts; const float vb_ = bf2f(Ub[(size_t)tc * NU + C_XBC + chB]), vc_ = bf2f(Ub[(size_t)tc * NU + C_XBC + chC]); rb[j] = ts < 0 ? 0.f : vb_; rc[j] = ts < 0 ? 0.f : vc_; }
        unsigned bt[8];
#pragma unroll
        for (int i = 0; i < 16; ++i) { float ab = bB, ac = bC;
#pragma unroll
            for (int k = 0; k < 4; ++k) { ab += wB[k] * rb[i + k]; ac += wC[k] * rc[i + k]; }
            const unsigned ub = f2bf(siluf_(ab)), uc = f2bf(siluf_(ac)); const int t = 16 * tq + i;
            img[t * 128 + n] = (bf16)ub; img[8192 + t * 128 + n] = (bf16)uc;
            if (i & 1) bt[i >> 1] |= ub << 16; else bt[i >> 1] = ub; }
        *(v4u*)(img + 16384 + n * 64 + tq * 16) = (v4u){bt[0], bt[1], bt[2], bt[3]};
        *(v4u*)(img + 16384 + n * 64 + tq * 16 + 8) = (v4u){bt[4], bt[5], bt[6], bt[7]};
    }
}
typedef short bf16x4_t __attribute__((ext_vector_type(4)));
typedef unsigned v2u __attribute__((ext_vector_type(2)));
#define MFMA16(a, b, c) __builtin_amdgcn_mfma_f32_16x16x32_bf16((a), (b), (c), 0, 0, 0)
__device__ __forceinline__ float clamp80(float x) { return fminf(fmaxf(x, -80.f), 80.f); }
__device__ __forceinline__ bf16x8 pack8(f32x4 lo, f32x4 hi) { v4u w; w.x = pk2(lo.x, lo.y); w.y = pk2(lo.z, lo.w); w.z = pk2(hi.x, hi.y); w.w = pk2(hi.z, hi.w); return __builtin_bit_cast(bf16x8, w); }
__device__ __forceinline__ v2u pack4(f32x4 v) { v2u w; w.x = pk2(v.x, v.y); w.y = pk2(v.z, v.w); return w; }
__device__ __forceinline__ bf16x8 ld8x2(const LAS unsigned char* p0, const LAS unsigned char* p1) {
    const v2u a = *(const LAS v2u*)p0, b = *(const LAS v2u*)p1; v4u w; w.x = a.x; w.y = a.y; w.z = b.x; w.w = b.y; return __builtin_bit_cast(bf16x8, w); }

__device__ __forceinline__ void hgrn_unit(Frame& F, KA A, int l, int b, int h) {
    constexpr int QT_OFF = 0, KT_OFF = 17408, KTT_OFF = 34816, VT_OFF = 53248, PT_OFF = 71680, PART_OFF = 80896, ER_OFF = 82944, EC_OFF = 83456;
    LAS unsigned char* L = F.lds + RING_OFF;
    const int tid = F.tid, lane = F.lane, wave = F.wave, fr = lane & 15, fq = lane >> 4;
    const int d = tid & 127, c = h * 128 + d, tq = tid >> 7;
    f32x4 S[8];
#pragma unroll
    for (int i = 0; i < 8; ++i) S[i] = (f32x4){0.f, 0.f, 0.f, 0.f};
    const int vb = h * 128 + 16 * wave + 4 * fq;
    const f32x4 nw4 = *(const f32x4*)(A->in[I_HGNW] + (size_t)l * 512 + vb);
    const bf16* Ub = P_U + (size_t)b * SEQ * NU;
    bf16* Yb = P_Y + (size_t)b * SEQ * DIN;
    float* SQb = P_SSQ + (size_t)b * SEQ * NSSQ;
    unsigned short rq[16], rf[16], rv[16];
    { const bf16* ur = Ub + (size_t)(16 * tq) * NU + C_HF + c;
#pragma unroll
      for (int i = 0; i < 16; ++i) { rq[i] = ur[-512]; rf[i] = ur[0]; rv[i] = ur[512]; ur += NU; asm volatile("" : "+v"(ur)); } }
    for (int chunk = 0; chunk < SEQ / 64; ++chunk) {
        const int t0 = chunk * 64;
        v2u gw[4];
#pragma unroll
        for (int tt = 0; tt < 4; ++tt) gw[tt] = *(const v2u*)(Ub + (size_t)(t0 + 16 * tt + fr) * NU + C_HG + vb);
        float qq[16], kk[16], cum[16];
        { unsigned vv[8];
          float run = 0.f;
#pragma unroll
          for (int i = 0; i < 16; ++i) { const float lf = bf2f(rf[i]);
              run += lf; cum[i] = run; kk[i] = 1.f - __expf(lf); qq[i] = bf2f(rq[i]);
              if (i & 1) vv[i >> 1] |= (unsigned)rv[i] << 16; else vv[i >> 1] = rv[i]; }
          ((LAS float*)(L + PART_OFF))[tq * 128 + d] = run;
          *(LAS v4u*)(L + VT_OFF + d * 144 + tq * 32) = (v4u){vv[0], vv[1], vv[2], vv[3]};
          *(LAS v4u*)(L + VT_OFF + d * 144 + tq * 32 + 16) = (v4u){vv[4], vv[5], vv[6], vv[7]}; }
        __syncthreads();
        { const LAS float* part = (const LAS float*)(L + PART_OFF);
          const float p0 = part[d], p1 = part[128 + d], p2 = part[256 + d], p3 = part[384 + d];
          const float r = p0 + p1, c63 = (p0 + p1) + (p2 + p3);
          const float pre = (tq == 0) ? 0.f : (tq == 1) ? p0 : (tq == 2) ? (p0 + p1) : (p0 + p1 + p2);
          unsigned kt[8];
#pragma unroll
          for (int i = 0; i < 16; ++i) { const float cm = cum[i] + pre;
              const float qv = qq[i] * __expf(clamp80(cm - r)), kv = kk[i] * __expf(clamp80(r - cm));
              const int t = 16 * tq + i;
              *(LAS bf16*)(L + QT_OFF + t * 272 + d * 2) = (bf16)f2bf(qv);
              const unsigned kb = f2bf(kv);
              *(LAS bf16*)(L + KT_OFF + t * 272 + d * 2) = (bf16)kb;
              if (i & 1) kt[i >> 1] |= kb << 16; else kt[i >> 1] = kb; }
          *(LAS v4u*)(L + KTT_OFF + d * 144 + tq * 32) = (v4u){kt[0], kt[1], kt[2], kt[3]};
          *(LAS v4u*)(L + KTT_OFF + d * 144 + tq * 32 + 16) = (v4u){kt[4], kt[5], kt[6], kt[7]};
          if (tq == 0) { ((LAS float*)(L + ER_OFF))[d] = __expf(clamp80(r)); ((LAS float*)(L + EC_OFF))[d] = __expf(clamp80(c63 - r)); } }
        { const int tn = (chunk + 1 < SEQ / 64) ? t0 + 64 : t0;
          const bf16* ur = Ub + (size_t)(tn + 16 * tq) * NU + C_HF + c;
#pragma unroll
          for (int i = 0; i < 16; ++i) { rq[i] = ur[-512]; rf[i] = ur[0]; rv[i] = ur[512]; ur += NU; asm volatile("" : "+v"(ur)); } }
        __syncthreads();
#pragma unroll
        for (int k2 = 0; k2 < 2; ++k2) { const int id = 2 * wave + k2, st = id >> 2, tt = id & 3;
            f32x4 acc = (f32x4){0.f, 0.f, 0.f, 0.f};
            if (st <= tt) {
#pragma unroll
                for (int ks = 0; ks < 4; ++ks) { const bf16x8 a = *(const LAS bf16x8*)(L + KT_OFF + (16 * st + fr) * 272 + (4 * ks + fq) * 16);
                    const bf16x8 bq = *(const LAS bf16x8*)(L + QT_OFF + (16 * tt + fr) * 272 + (4 * ks + fq) * 16);
                    acc = MFMA16(a, bq, acc); }
                if (st == tt) {
#pragma unroll
                    for (int r4 = 0; r4 < 4; ++r4) if (4 * fq + r4 > fr) acc[r4] = 0.f; } }
            *(LAS v2u*)(L + PT_OFF + (16 * tt + fr) * 144 + (16 * st + 4 * fq) * 2) = pack4(acc); }
        __syncthreads();
        { const LAS float* er = (const LAS float*)(L + ER_OFF);
#pragma unroll
          for (int i = 0; i < 8; ++i) S[i] = S[i] * *(const LAS f32x4*)(er + 16 * i + 4 * fq); }
        f32x4 o[4];
#pragma unroll
        for (int tt = 0; tt < 4; ++tt) o[tt] = (f32x4){0.f, 0.f, 0.f, 0.f};
#pragma unroll
        for (int ks = 0; ks < 4; ++ks) { const bf16x8 sa = pack8(S[2 * ks], S[2 * ks + 1]);
#pragma unroll
            for (int tt = 0; tt < 4; ++tt) { const LAS unsigned char* qrow = L + QT_OFF + (16 * tt + fr) * 272 + (32 * ks + 4 * fq) * 2;
                o[tt] = MFMA16(sa, ld8x2(qrow, qrow + 32), o[tt]); } }
        bf16x8 va[2];
#pragma unroll
        for (int ks2 = 0; ks2 < 2; ++ks2) va[ks2] = *(const LAS bf16x8*)(L + VT_OFF + (16 * wave + fr) * 144 + (32 * ks2 + 8 * fq) * 2);
#pragma unroll
        for (int ks2 = 0; ks2 < 2; ++ks2)
#pragma unroll
            for (int tt = 0; tt < 4; ++tt) if (32 * ks2 <= 16 * tt + 15) {
                const bf16x8 pb = *(const LAS bf16x8*)(L + PT_OFF + (16 * tt + fr) * 144 + (32 * ks2 + 8 * fq) * 2);
                o[tt] = MFMA16(va[ks2], pb, o[tt]); }
#pragma unroll
        for (int i = 0; i < 8; ++i)
#pragma unroll
            for (int ks2 = 0; ks2 < 2; ++ks2) { const bf16x8 ka = *(const LAS bf16x8*)(L + KTT_OFF + (16 * i + fr) * 144 + (32 * ks2 + 8 * fq) * 2);
                S[i] = MFMA16(ka, va[ks2], S[i]); }
        { const LAS float* ec = (const LAS float*)(L + EC_OFF);
#pragma unroll
          for (int i = 0; i < 8; ++i) S[i] = S[i] * *(const LAS f32x4*)(ec + 16 * i + 4 * fq); }
#pragma unroll
        for (int tt = 0; tt < 4; ++tt) { const size_t t = t0 + 16 * tt + fr;
            f32x4 g4; g4.x = __uint_as_float(gw[tt].x << 16); g4.y = __uint_as_float(gw[tt].x & 0xffff0000u); g4.z = __uint_as_float(gw[tt].y << 16); g4.w = __uint_as_float(gw[tt].y & 0xffff0000u);
            const f32x4 ov = o[tt];
            float ss = (ov.x * ov.x + ov.y * ov.y) + (ov.z * ov.z + ov.w * ov.w);
            ss += __shfl_xor(ss, 16); ss += __shfl_xor(ss, 32);
            const f32x4 yv = ov * nw4 * g4;
            *(v2u*)(Yb + t * DIN + Y_B + vb) = pack4(yv);
            if (fq == 0) SQb[t * NSSQ + 64 + h * 8 + wave] = ss; }
        __syncthreads();
    }
}
__device__ __forceinline__ void ssd_unit(Frame& F, KA A, int l, int b, int hh) {
    constexpr int BM_OFF = 0, CM_OFF = 17408, BT_OFF = 34816, XT_OFF = 53248, WT_OFF = 62464, SB_OFF = 71680, SC_OFF = 106496;
    LAS unsigned char* L = F.lds + RING_OFF;
    const int tid = F.tid, lane = F.lane, wave = F.wave, fr = lane & 15, fq = lane >> 4;
    const int g = hh >> 3, p = tid & 63, t8 = tid >> 6;
    const float* cwp = A->in[I_SCW] + (size_t)l * 4 * 1536; const float* cbp = A->in[I_SCB] + (size_t)l * 1536;
    const int chX = hh * 64 + p;
    float wX[4];
#pragma unroll
    for (int k = 0; k < 4; ++k) wX[k] = cwp[k * 1536 + chX];
    const float bX = cbp[chX];
    const float Ah = -__expf(A->in[I_SALOG][l * 16 + hh]), Dh = A->in[I_SD][l * 16 + hh];
    const int pt = wave >> 1, tts = (wave & 1) * 2;
    const int pb = hh * 64 + 16 * pt + 4 * fq;
    const f32x4 nw4 = *(const f32x4*)(A->in[I_SNW] + (size_t)l * 1024 + pb);
    f32x4 ST[4];
#pragma unroll
    for (int i = 0; i < 4; ++i) ST[i] = (f32x4){0.f, 0.f, 0.f, 0.f};
    for (int i = tid; i < 17408 / 16; i += NTHREADS) *(LAS v4u*)(L + SB_OFF + i * 16) = (v4u){0u, 0u, 0u, 0u};
    const bf16* Ub = P_U + (size_t)b * SEQ * NU;
    bf16* Yb = P_Y + (size_t)b * SEQ * DIN;
    float* SQb = P_SSQ + (size_t)b * SEQ * NSSQ;
    const float* DTb = P_DT + (size_t)b * SEQ * 16;
    LAS float* SC = (LAS float*)(L + SC_OFF);
    const unsigned char* IMG = (const unsigned char*)(A->ws + WS_BC) + (size_t)((b * 2 + g) * 32) * 49152 + tid * 16;
    v4u pfB[2], pfC[2], pfT[2]; unsigned short pfx[11]; v2u pfz[2]; float pfdt;
#define SSD_PREFETCH(cn) do { const unsigned char* im = IMG + (size_t)(cn) * 49152; \
        pfB[0] = *(const v4u*)(im); pfB[1] = *(const v4u*)(im + 8192); pfC[0] = *(const v4u*)(im + 16384); pfC[1] = *(const v4u*)(im + 24576); pfT[0] = *(const v4u*)(im + 32768); pfT[1] = *(const v4u*)(im + 40960); \
        { const int tb = (cn) * 64 + 8 * t8 - 3; _Pragma("unroll") for (int j = 0; j < 11; ++j) { const int ts = tb + j, tc = ts < 0 ? 0 : ts; pfx[j] = Ub[(size_t)tc * NU + C_XBC + chX]; } } \
        _Pragma("unroll") for (int k2 = 0; k2 < 2; ++k2) pfz[k2] = *(const v2u*)(Ub + (size_t)((cn) * 64 + 16 * (tts + k2) + fr) * NU + C_Z + pb); \
        pfdt = DTb[(size_t)((cn) * 64 + lane) * 16 + hh]; } while (0)
    SSD_PREFETCH(0);
    for (int chunk = 0; chunk < SEQ / 64; ++chunk) {
        const int t0 = chunk * 64, cur = chunk & 1;
        { const int q0 = tid, q1 = tid + 512;
          *(LAS v4u*)(L + BM_OFF + (q0 >> 4) * 272 + (q0 & 15) * 16) = pfB[0]; *(LAS v4u*)(L + BM_OFF + (q1 >> 4) * 272 + (q1 & 15) * 16) = pfB[1];
          *(LAS v4u*)(L + CM_OFF + (q0 >> 4) * 272 + (q0 & 15) * 16) = pfC[0]; *(LAS v4u*)(L + CM_OFF + (q1 >> 4) * 272 + (q1 & 15) * 16) = pfC[1];
          *(LAS v4u*)(L + BT_OFF + (q0 >> 3) * 144 + (q0 & 7) * 16) = pfT[0]; *(LAS v4u*)(L + BT_OFF + (q1 >> 3) * 144 + (q1 & 7) * 16) = pfT[1]; }
        { unsigned xt[4];
#pragma unroll
          for (int i = 0; i < 8; ++i) { float ax = bX;
#pragma unroll
              for (int k = 0; k < 4; ++k) { const float xv = (chunk == 0 && 8 * t8 + i + k < 3) ? 0.f : bf2f(pfx[i + k]); ax += wX[k] * xv; }
              const unsigned ux = f2bf(siluf_(ax));
              if (i & 1) xt[i >> 1] |= ux << 16; else xt[i >> 1] = ux; }
          *(LAS v4u*)(L + XT_OFF + p * 144 + t8 * 16) = (v4u){xt[0], xt[1], xt[2], xt[3]}; }
        if (wave == 0) { const float dtv = pfdt; float cs = dtv * Ah;
#pragma unroll
            for (int off = 1; off < 64; off <<= 1) { const float v = __shfl_up(cs, off); if (lane >= off) cs += v; }
            const float c63 = __shfl(cs, 63);
            SC[lane] = cs; SC[64 + lane] = __expf(cs); SC[128 + lane] = dtv * __expf(c63 - cs); SC[192 + lane] = dtv; }
        const v2u zc0 = pfz[0], zc1 = pfz[1];
        { const int cn = (chunk + 1 < SEQ / 64) ? chunk + 1 : chunk; SSD_PREFETCH(cn); }
        __syncthreads();
#pragma unroll
        for (int k2 = 0; k2 < 2; ++k2) { const int id = 2 * wave + k2, st = id >> 2, tt = id & 3;
            f32x4 acc = (f32x4){0.f, 0.f, 0.f, 0.f};
            if (st <= tt) {
#pragma unroll
                for (int ks = 0; ks < 4; ++ks) { const bf16x8 a = *(const LAS bf16x8*)(L + BM_OFF + (16 * st + fr) * 272 + (4 * ks + fq) * 16);
                    const bf16x8 cq = *(const LAS bf16x8*)(L + CM_OFF + (16 * tt + fr) * 272 + (4 * ks + fq) * 16);
                    acc = MFMA16(a, cq, acc); }
                const float ct = SC[16 * tt + fr];
                const f32x4 cs4 = *(const LAS f32x4*)(SC + 16 * st + 4 * fq), dt4 = *(const LAS f32x4*)(SC + 192 + 16 * st + 4 * fq);
#pragma unroll
                for (int r4 = 0; r4 < 4; ++r4) { const int sl = 16 * st + 4 * fq + r4, tl = 16 * tt + fr;
                    float v = acc[r4] * __expf(fminf(ct - cs4[r4], 0.f)) * dt4[r4];
                    if (sl == tl) v += Dh;
                    acc[r4] = (sl <= tl) ? v : 0.f; } }
            *(LAS v2u*)(L + WT_OFF + (16 * tt + fr) * 144 + (16 * st + 4 * fq) * 2) = pack4(acc); }
        __syncthreads();
        { f32x4 y[2];
          y[0] = (f32x4){0.f, 0.f, 0.f, 0.f}; y[1] = y[0];
#pragma unroll
          for (int ks = 0; ks < 4; ++ks) { const bf16x8 sa = *(const LAS bf16x8*)(L + SB_OFF + cur * 17408 + (16 * pt + fr) * 272 + (4 * ks + fq) * 16);
#pragma unroll
              for (int k2 = 0; k2 < 2; ++k2) { const bf16x8 cq = *(const LAS bf16x8*)(L + CM_OFF + (16 * (tts + k2) + fr) * 272 + (4 * ks + fq) * 16);
                  y[k2] = MFMA16(sa, cq, y[k2]); } }
#pragma unroll
          for (int k2 = 0; k2 < 2; ++k2) y[k2] = y[k2] * SC[64 + 16 * (tts + k2) + fr];
#pragma unroll
          for (int ks2 = 0; ks2 < 2; ++ks2) { const bf16x8 xa = *(const LAS bf16x8*)(L + XT_OFF + (16 * pt + fr) * 144 + (32 * ks2 + 8 * fq) * 2);
#pragma unroll
              for (int k2 = 0; k2 < 2; ++k2) if (32 * ks2 <= 16 * (tts + k2) + 15) {
                  const bf16x8 wb = *(const LAS bf16x8*)(L + WT_OFF + (16 * (tts + k2) + fr) * 144 + (32 * ks2 + 8 * fq) * 2);
                  y[k2] = MFMA16(xa, wb, y[k2]); } }
#pragma unroll
          for (int k2 = 0; k2 < 2; ++k2) { const size_t t = t0 + 16 * (tts + k2) + fr;
              const v2u zw = k2 ? zc1 : zc0;
              f32x4 z4; z4.x = __uint_as_float(zw.x << 16); z4.y = __uint_as_float(zw.x & 0xffff0000u); z4.z = __uint_as_float(zw.y << 16); z4.w = __uint_as_float(zw.y & 0xffff0000u);
              const f32x4 v = y[k2] * z4;
              float ss = (v.x * v.x + v.y * v.y) + (v.z * v.z + v.w * v.w);
              ss += __shfl_xor(ss, 16); ss += __shfl_xor(ss, 32);
              *(v2u*)(Yb + t * DIN + Y_C + pb) = pack4(v * nw4);
              if (fq == 0) SQb[t * NSSQ + hh * 4 + pt] = ss; } }
        { const float dec = SC[64 + 63];
#pragma unroll
          for (int i = 0; i < 4; ++i) ST[i] = ST[i] * dec;
#pragma unroll
          for (int ks2 = 0; ks2 < 2; ++ks2) { const bf16x8 ba = *(const LAS bf16x8*)(L + BT_OFF + (16 * wave + fr) * 144 + (32 * ks2 + 8 * fq) * 2);
              const f32x4 w0 = *(const LAS f32x4*)(SC + 128 + 32 * ks2 + 8 * fq), w1 = *(const LAS f32x4*)(SC + 128 + 32 * ks2 + 8 * fq + 4);
#pragma unroll
              for (int i = 0; i < 4; ++i) { const v4u xr = *(const LAS v4u*)(L + XT_OFF + (16 * i + fr) * 144 + (32 * ks2 + 8 * fq) * 2);
                  f32x4 lo, hi; lo.x = __uint_as_float(xr.x << 16) * w0.x; lo.y = __uint_as_float(xr.x & 0xffff0000u) * w0.y; lo.z = __uint_as_float(xr.y << 16) * w0.z; lo.w = __uint_as_float(xr.y & 0xffff0000u) * w0.w;
                  hi.x = __uint_as_float(xr.z << 16) * w1.x; hi.y = __uint_as_float(xr.z & 0xffff0000u) * w1.y; hi.z = __uint_as_float(xr.w << 16) * w1.z; hi.w = __uint_as_float(xr.w & 0xffff0000u) * w1.w;
                  ST[i] = MFMA16(ba, pack8(lo, hi), ST[i]); } }
#pragma unroll
          for (int i = 0; i < 4; ++i) *(LAS v2u*)(L + SB_OFF + (cur ^ 1) * 17408 + (16 * i + fr) * 272 + (16 * wave + 4 * fq) * 2) = pack4(ST[i]); }
        __syncthreads();
    }
}
__device__ __forceinline__ void lru_unit2(Frame& F, KA A, int l, int b, int hd) {
    constexpr int WAT_OFF = 0, WXT_OFF = 9216, XB_OFF = 18432, XA_OFF = 27648, AA_OFF = 44288, BB_OFF = 60672;
    LAS unsigned char* L = F.lds + RING_OFF;
    LAS float* XA = (LAS float*)(L + XA_OFF); LAS float* AA = (LAS float*)(L + AA_OFF); LAS float* BB = (LAS float*)(L + BB_OFF);
    const int tid = F.tid, lane = F.lane, wave = F.wave, fr = lane & 15, fq = lane >> 4;
    const int c0 = hd * 64;
    { const float* wa = A->in[I_LWA] + (size_t)(l * 8 + hd) * 4096; const float* wx = A->in[I_LWX] + (size_t)(l * 8 + hd) * 4096;
      for (int e = tid; e < 4096; e += NTHREADS) { const int i = e >> 6, jj = e & 63;
          *(LAS bf16*)(L + WAT_OFF + jj * 144 + i * 2) = (bf16)f2bf(wa[e]); *(LAS bf16*)(L + WXT_OFF + jj * 144 + i * 2) = (bf16)f2bf(wx[e]); } }
    const int j = tid & 63;
    float cw[4];
#pragma unroll
    for (int k = 0; k < 4; ++k) cw[k] = A->in[I_LCW][(size_t)(l * 4 + k) * 512 + c0 + j];
    const float cbias = A->in[I_LCB][(size_t)l * 512 + c0 + j];
    const int tt = wave >> 1, jts = (wave & 1) * 2;
    float ba[2], bx[2], sp[2];
#pragma unroll
    for (int k2 = 0; k2 < 2; ++k2) { const int ch = c0 + 16 * (jts + k2) + fr; ba[k2] = A->in[I_LBA][(size_t)l * 512 + ch]; bx[k2] = A->in[I_LBX][(size_t)l * 512 + ch]; sp[k2] = softplusf_(-A->in[I_LLAM][(size_t)l * 512 + ch]); }
    float hcar = 0.f;
    const bf16* Ub = P_U + (size_t)b * SEQ * NU;
    bf16* Yb = P_Y + (size_t)b * SEQ * DIN;
    __syncthreads();
    unsigned short pfx[11], pfg[8];
#define LRU_PREFETCH(tn) do { const int tb = (tn) * 64 + 8 * wave - 3; \
        _Pragma("unroll") for (int q = 0; q < 11; ++q) { const int ts = tb + q, tc = ts < 0 ? 0 : ts; pfx[q] = Ub[(size_t)tc * NU + C_AX + c0 + j]; } \
        _Pragma("unroll") for (int i = 0; i < 8; ++i) pfg[i] = Ub[(size_t)((tn) * 64 + 8 * wave + i) * NU + C_AG + c0 + j]; } while (0)
    LRU_PREFETCH(0);
    for (int tile = 0; tile < SEQ / 64; ++tile) {
        const int t0 = tile * 64;
        float gv[8];
        {
#pragma unroll
          for (int i = 0; i < 8; ++i) { float a = cbias;
#pragma unroll
              for (int k = 0; k < 4; ++k) { const float xv = (tile == 0 && 8 * wave + i + k < 3) ? 0.f : bf2f(pfx[i + k]); a += cw[k] * xv; }
              const int t = 8 * wave + i; XA[t * 65 + j] = a; *(LAS bf16*)(L + XB_OFF + t * 144 + j * 2) = (bf16)f2bf(a); gv[i] = bf2f(pfg[i]); } }
        { const int tn = (tile + 1 < SEQ / 64) ? tile + 1 : tile; LRU_PREFETCH(tn); }
        __syncthreads();
        { f32x4 ra[2], ia[2];
#pragma unroll
          for (int k2 = 0; k2 < 2; ++k2) { ra[k2] = (f32x4){0.f, 0.f, 0.f, 0.f}; ia[k2] = ra[k2]; }
#pragma unroll
          for (int ks = 0; ks < 2; ++ks) { const bf16x8 xa = *(const LAS bf16x8*)(L + XB_OFF + (16 * tt + fr) * 144 + (32 * ks + 8 * fq) * 2);
#pragma unroll
              for (int k2 = 0; k2 < 2; ++k2) { const bf16x8 wa8 = *(const LAS bf16x8*)(L + WAT_OFF + (16 * (jts + k2) + fr) * 144 + (32 * ks + 8 * fq) * 2);
                  const bf16x8 wx8 = *(const LAS bf16x8*)(L + WXT_OFF + (16 * (jts + k2) + fr) * 144 + (32 * ks + 8 * fq) * 2);
                  ra[k2] = MFMA16(xa, wa8, ra[k2]); ia[k2] = MFMA16(xa, wx8, ia[k2]); } }
#pragma unroll
          for (int k2 = 0; k2 < 2; ++k2)
#pragma unroll
              for (int r4 = 0; r4 < 4; ++r4) { const int t = 16 * tt + 4 * fq + r4, jc = 16 * (jts + k2) + fr;
                  const float rg = sigmoidf_(ra[k2][r4] + ba[k2]), ig = sigmoidf_(ia[k2][r4] + bx[k2]); const float la = -8.0f * rg * sp[k2]; const float a = __expf(la);
                  const float x2 = 2.0f * la;
                  const float om = (x2 > -0.1f) ? -x2 * (1.f + x2 * (0.5f + x2 * (0.16666667f + x2 * 0.041666668f))) : 1.f - __expf(x2);
                  AA[t * 64 + jc] = a; BB[t * 64 + jc] = sqrtf(fmaxf(om, 0.f)) * (ig * XA[t * 65 + jc]); } }
        __syncthreads();
        if (wave == 0) {
#pragma unroll
            for (int tb = 0; tb < 64; tb += 16) { float av[16], bv[16];
#pragma unroll
                for (int i = 0; i < 16; ++i) { av[i] = AA[(tb + i) * 64 + lane]; bv[i] = BB[(tb + i) * 64 + lane]; }
#pragma unroll
                for (int i = 0; i < 16; ++i) { hcar = av[i] * hcar + bv[i]; av[i] = hcar; }
#pragma unroll
                for (int i = 0; i < 16; ++i) XA[(tb + i) * 65 + lane] = av[i]; } }
        __syncthreads();
#pragma unroll
        for (int i = 0; i < 8; ++i) { const int t = 8 * wave + i;
            Yb[(size_t)(t0 + t) * DIN + Y_A + c0 + j] = (bf16)f2bf(XA[t * 65 + j] * gv[i]); }
        __syncthreads();
    }
}
__device__ __forceinline__ void mixer_phase2(Frame& F0, KA A, int l) {
    for (int un = F0.vcu; un < 224; un += F0.G) {
        Frame F = F0; { int t = F0.tid; asm volatile("" : "+v"(t)); F.tid = t; F.lane = t & 63; F.wave = __builtin_amdgcn_readfirstlane(t >> 6); }
        if (un < 128) { ssd_unit(F, A, l, un >> 4, un & 15); if (DUP_MASK & 32) { __syncthreads(); ssd_unit(F, A, l, un >> 4, un & 15); } }
        else if (un < 192) { lru_unit2(F, A, l, (un - 128) >> 3, (un - 128) & 7); if (DUP_MASK & 64) { __syncthreads(); lru_unit2(F, A, l, (un - 128) >> 3, (un - 128) & 7); } }
        else { hgrn_unit(F, A, l, (un - 192) >> 2, (un - 192) & 3); if (DUP_MASK & 128) { __syncthreads(); hgrn_unit(F, A, l, (un - 192) >> 2, (un - 192) & 3); } }
        __syncthreads();
    }
}
constexpr int NPHASES = 2 + 6 * DEPTH;
#ifndef MK_ONE_LAUNCH
#define MK_ONE_LAUNCH 1
#endif
__global__ void __launch_bounds__(NTHREADS, 2) hybrid_fwd(Args args) {
    extern __shared__ __attribute__((aligned(16))) unsigned char lds[];
    const KA Ak = (KA)__builtin_amdgcn_kernarg_segment_ptr();
    for (int u = threadIdx.x; u < (LDS_BYTES - LDSCTL_OFF) / 4; u += NTHREADS) ((LAS unsigned*)((LAS unsigned char*)lds + LDSCTL_OFF))[u] = 0u;
    __syncthreads();
    const int lo = Ak->ph_lo, hi = Ak->ph_hi;
    XcdBarrier bar; bar.bar = (unsigned*)(Ak->ws + WS_CTL) + CW_BAR; bar.x = 0; bar.st = nullptr;
    if (hi - lo > 1) bar = xcd_barrier_post((unsigned*)(Ak->ws + WS_CTL) + CW_BAR, (volatile LAS unsigned*)((LAS unsigned char*)lds + MISC_OFF) + 8);

    unsigned long long tacc = 0ull;
    for (int ph = lo; ph < hi; ++ph) {
        const unsigned long long ts0 = PROBE_TS ? __builtin_amdgcn_s_memrealtime() : 0ull;
        KA A = Ak; asm volatile("" : "+s"(A));
        Frame F;
        { int tid = threadIdx.x; asm volatile("" : "+v"(tid)); F.tid = tid; F.lane = tid & 63; F.wave = __builtin_amdgcn_readfirstlane(tid >> 6); }
        { int G = gridDim.x, bx = blockIdx.x; asm volatile("" : "+s"(G), "+s"(bx)); F.G = G; F.bx = bx; F.vcu = (G % 8 == 0) ? (bx % 8) * (G / 8) + bx / 8 : bx; }
        { unsigned lb = 0; asm volatile("" : "+s"(lb)); F.lds = (LAS unsigned char*)lds + lb; }
        if (ph == 0) { p0_prologue(F, A); if (DUP_MASK & 1) { __syncthreads(); p0_prologue(F, A); } }
        else if (ph == 1) { norm_phase(F, A, A->in[I_X], 0); if (DUP_MASK & 2) norm_phase(F, A, A->in[I_X], 0); }
        else {
            const int l = (ph - 2) / 6, sub = (ph - 2) % 6;
            if (sub == 0) {
                pg8::Gemm g{P_H, P_WIN + (size_t)l * NIN_PAD * DM, M, NIN_PAD, DM}; pg8::StaticOrder S; S.init(M, NIN_PAD, F.G, F.bx);
                pg8::EpiU E{P_U, NU, P_DT, NU / 256, P_LB + l * 512, A->in[I_SDTB] + l * 16};
                pg8::gemm_phase<pg8::EpiU, pg8::StaticOrder, true, true>(F.lds + RING_OFF, g, S, E, F.tid);
                if (DUP_MASK & 4) { __syncthreads(); pg8::gemm_phase<pg8::EpiU, pg8::StaticOrder, true, true>(F.lds + RING_OFF, g, S, E, F.tid); }
            } else if (sub == 1) {
                bc_prepass(F, A, l);
            } else if (sub == 2) {
                mixer_phase2(F, A, l);
                if (DUP_MASK & 8) { __syncthreads(); mixer_phase2(F, A, l); }
            } else if (sub == 3) {
                ynorm_phase(F, A);
            } else if (sub == 4) {
                pg8::Gemm g{P_Y, P_WOUT + (size_t)l * DM * DIN, M, DM, DIN}; pg8::StaticOrder S; S.init(M, DM, F.G, F.bx);
                pg8::EpiResid E{l == 0 ? A->in[I_X] : A->out, A->out, DM, P_MOD + (size_t)l * BATCH * 3 * DM + 2 * DM, 3 * DM, SEQ};
                pg8::gemm_phase<pg8::EpiResid, pg8::StaticOrder, true, true>(F.lds + RING_OFF, g, S, E, F.tid);
            } else {
                if (l + 1 < DEPTH) norm_phase(F, A, A->out, l + 1); else final_norm_phase(F, A);
            }
        }
        if (PROBE_TS) { const unsigned long long ts1 = __builtin_amdgcn_s_memrealtime();
            const int cls = (ph == 0) ? 1 : (ph == 1) ? 2 : ((ph - 2) % 6 == 0) ? 3 : ((ph - 2) % 6 == 1) ? 8 : ((ph - 2) % 6 == 2) ? 4 : ((ph - 2) % 6 == 3) ? 5 : ((ph - 2) % 6 == 4) ? 6 : 2;
            if (cls == PROBE_TS) tacc += ts1 - ts0; }
        if (ph + 1 < hi) { const unsigned long long tb0 = PROBE_TS ? __builtin_amdgcn_s_memrealtime() : 0ull; xcd_barrier(bar); if (PROBE_TS == 7) tacc += __builtin_amdgcn_s_memrealtime() - tb0; if (DUP_MASK & 16) { xcd_barrier(bar); xcd_barrier(bar); xcd_barrier(bar); xcd_barrier(bar); } }
    }
    if (PROBE_TS) { xcd_barrier(bar); const int vcu = (gridDim.x % 8 == 0) ? (blockIdx.x % 8) * (gridDim.x / 8) + blockIdx.x / 8 : blockIdx.x;
        if (vcu == PROBE_VCU && threadIdx.x == 0) Ak->out[0] = 100.0f * floorf((float)tacc * 0.01f / 100.0f + PROBE_OFS); }
}

extern "C" void kernel_launch(void* const* d_in, const int* in_sizes, int n_in, void* d_out, int out_size, void* d_ws, size_t ws_size, hipStream_t stream) {
    static int grid = 0;
    if (grid == 0) {
        if (n_in != 23 || in_sizes[0] != M * DM || out_size != M * DM || ws_size < WS_END) { fprintf(stderr, "kernel_launch: unexpected shapes: n_in %d in0 %d out %d ws %zu (need %zu)\n", n_in, n_in > 0 ? in_sizes[0] : -1, out_size, ws_size, (size_t)WS_END); grid = -1; return; }
        int dev = 0, cus = 0, per_cu = 0;
        if (hipGetDevice(&dev) != hipSuccess || hipDeviceGetAttribute(&cus, hipDeviceAttributeMultiprocessorCount, dev) != hipSuccess) { grid = -1; return; }
        if (hipFuncSetAttribute((const void*)hybrid_fwd, hipFuncAttributeMaxDynamicSharedMemorySize, LDS_BYTES) != hipSuccess) { fprintf(stderr, "kernel_launch: hipFuncSetAttribute failed\n"); grid = -1; return; }
        if (hipOccupancyMaxActiveBlocksPerMultiprocessor(&per_cu, (const void*)hybrid_fwd, NTHREADS, LDS_BYTES) != hipSuccess || per_cu < 1)
            fprintf(stderr, "kernel_launch: note: occupancy query reports %d workgroups per CU\n", per_cu);
        (void)hipGetLastError();
        grid = cus;
    }
    if (grid < 0) return;
    if (hipMemsetAsync((char*)d_ws + WS_CTL, 0, CTL_ZERO_BYTES, stream) != hipSuccess) return;
    Args a{};
    for (int i = 0; i < 23; ++i) a.in[i] = (const float*)d_in[i];
    a.out = (float*)d_out; a.ws = (unsigned char*)d_ws;
#if MK_ONE_LAUNCH
    a.ph_lo = 0; a.ph_hi = NPHASES;
    hipLaunchKernelGGL(hybrid_fwd, dim3(grid), dim3(NTHREADS), LDS_BYTES, stream, a);
#else
    for (int ph = 0; ph < NPHASES; ++ph) { a.ph_lo = ph; a.ph_hi = ph + 1; hipLaunchKernelGGL(hybrid_fwd, dim3(grid), dim3(NTHREADS), LDS_BYTES, stream, a); }
#endif
}
```
